# Optimizing an MI355X kernel written in HIP

```python
import jax
import jax.numpy as jnp
from jax import lax
import numpy as np

D_MODEL = 2048
BATCH = 1
SEQ = 8192
DEPTH = 2

GLA_V = D_MODEL // 2
GLA_DV = 128
GLA_HEADS = GLA_V // GLA_DV
GLA_DK = GLA_DV // 2
GLA_QK = GLA_HEADS * GLA_DK
GLA_GATE_RANK = 16
GLA_TAU = 16.0
GLA_CHUNK = 64

RWKV_WIDTH = D_MODEL - GLA_V
RWKV_HEAD = 64
RWKV_HEADS = RWKV_WIDTH // RWKV_HEAD
RWKV_W_RANK = 96
RWKV_A_RANK = 96
RWKV_G_RANK = 256
RWKV_V_RANK = 64
RWKV_GN_EPS = 64e-5

D_MIX = GLA_V + RWKV_WIDTH
D_FF = 4 * D_MODEL
RMS_EPS = 1e-6

GLA_SPLITS = (GLA_QK, GLA_QK, GLA_V, GLA_V, GLA_GATE_RANK)
RWKV_SPLITS = (RWKV_WIDTH, RWKV_WIDTH, RWKV_WIDTH, RWKV_W_RANK, RWKV_A_RANK, RWKV_G_RANK)
GLA_COLS = sum(GLA_SPLITS)
RWKV_COLS = sum(RWKV_SPLITS)
N_IN = GLA_COLS + RWKV_COLS

kernel_name = 'hymba_gla_rwkv7_hybrid'


def rmsnorm(x, g):
    xf = x.astype(jnp.float32)
    y = xf * lax.rsqrt(jnp.mean(xf * xf, axis=-1, keepdims=True) + RMS_EPS)
    return (y * g.astype(jnp.float32)).astype(x.dtype)


def token_shift(z):
    return jnp.pad(z, ((0, 0), (1, 0), (0, 0)))[:, :-1]


def lerp_shift(z, mu):
    return z + mu * (token_shift(z) - z)


def split_cols(z, sizes):
    return jnp.split(z, np.cumsum(sizes)[:-1].tolist(), axis=-1)


def gla_mixer(q, k, v, g, a_low, w_a_up, b_a, norm_w):
    f32 = jnp.float32
    B, T, _ = q.shape
    H, DK, DV, C = GLA_HEADS, GLA_DK, GLA_DV, GLA_CHUNK
    n_chunks = T // C
    log_a = jax.nn.log_sigmoid(a_low.astype(f32) @ w_a_up.astype(f32) + b_a.astype(f32)) / GLA_TAU

    def to_chunks(z, d):
        return z.astype(f32).reshape(B, n_chunks, C, H, d).transpose(1, 0, 3, 2, 4)

    qc = to_chunks(q, DK) * (DK ** -0.5)
    kc = to_chunks(k, DK)
    vc = to_chunks(v, DV)
    lac = to_chunks(log_a, DK)
    causal = jnp.tril(jnp.ones((C, C), dtype=bool))[None, None, :, :, None]

    def chunk_step(S, inp):
        qi, ki, vi, lai = inp
        b = jnp.cumsum(lai, axis=2)
        o_inter = jnp.einsum('bhck,bhkv->bhcv', qi * jnp.exp(b), S)
        rel = b[:, :, :, None, :] - b[:, :, None, :, :]
        decay = jnp.where(causal, jnp.exp(jnp.minimum(rel, 0.0)), 0.0)
        scores = jnp.einsum('bhik,bhjk,bhijk->bhij', qi, ki, decay)
        o_intra = jnp.einsum('bhij,bhjv->bhiv', scores, vi)
        b_last = b[:, :, -1:, :]
        S = S * jnp.exp(b_last[:, :, 0, :, None]) + jnp.einsum('bhck,bhcv->bhkv', ki * jnp.exp(b_last - b), vi)
        return S, o_inter + o_intra

    S0 = jnp.zeros((B, H, DK, DV), f32)
    _, o = lax.scan(chunk_step, S0, (qc, kc, vc, lac))
    o = o.transpose(1, 0, 3, 2, 4).reshape(B, T, H, DV)
    o = o * lax.rsqrt(jnp.mean(o * o, axis=-1, keepdims=True) + RMS_EPS)
    o = o.reshape(B, T, GLA_V) * norm_w.astype(f32)
    return (o * jax.nn.silu(g.astype(f32))).astype(q.dtype)


def rwkv7_mixer(r, k, v, w_low, a_low, g_low, w0, w_up, a0, a_up, g_up, k_k, k_a, r_k, gn_w, gn_b):
    f32 = jnp.float32
    B, T, _ = r.shape
    H, N = RWKV_HEADS, RWKV_HEAD
    out_dtype = r.dtype
    r, k, v, w_low, a_low, g_low = (z.astype(f32) for z in (r, k, v, w_low, a_low, g_low))
    w = -jax.nn.softplus(-(w0.astype(f32) + jnp.tanh(w_low) @ w_up.astype(f32))) - 0.5
    decay = jnp.exp(-jnp.exp(w))
    a = jax.nn.sigmoid(a0.astype(f32) + a_low @ a_up.astype(f32))
    gate = jax.nn.sigmoid(g_low) @ g_up.astype(f32)
    kk = (k * k_k.astype(f32)).reshape(B, T, H, N)
    kk = kk * lax.rsqrt(jnp.maximum(jnp.sum(kk * kk, axis=-1, keepdims=True), 1e-24))
    k = k * (1.0 + (a - 1.0) * k_a.astype(f32))
    rh = r.reshape(B, T, H, N)
    kh = k.reshape(B, T, H, N)
    vh = v.reshape(B, T, H, N)
    wh = decay.reshape(B, T, H, N)
    ah = a.reshape(B, T, H, N)

    def tm(z):
        return jnp.moveaxis(z, 1, 0)

    def step(S, inp):
        r_t, w_t, k_t, v_t, a_t, b_t = inp
        sa = jnp.einsum('bhvk,bhk->bhv', S, a_t)
        S = S * w_t[:, :, None, :] + sa[..., None] * b_t[:, :, None, :] + v_t[..., None] * k_t[:, :, None, :]
        return S, jnp.einsum('bhvk,bhk->bhv', S, r_t)

    S0 = jnp.zeros((B, H, N, N), f32)
    _, y = lax.scan(step, S0, (tm(rh), tm(wh), tm(kh), tm(vh), tm(-kk), tm(kk * ah)))
    y = jnp.moveaxis(y, 0, 1)
    mu = jnp.mean(y, axis=-1, keepdims=True)
    var = jnp.mean(jnp.square(y - mu), axis=-1, keepdims=True)
    y = ((y - mu) * lax.rsqrt(var + RWKV_GN_EPS)).reshape(B, T, RWKV_WIDTH)
    y = y * gn_w.astype(f32) + gn_b.astype(f32)
    bonus = jnp.sum(rh * kh * r_k.astype(f32), axis=-1, keepdims=True) * vh
    y = y + bonus.reshape(B, T, RWKV_WIDTH)
    return (y * gate).astype(out_dtype)


def setup_inputs(seed: int = 0) -> dict:
    key = jax.random.key(seed)
    ks = list(jax.random.split(key, 40))
    it = iter(ks)

    def nrm(shape, scale):
        return scale * jax.random.normal(next(it), shape, jnp.float32)

    def unif(shape):
        return jax.random.uniform(next(it), shape, jnp.float32)

    D, L, RW = D_MODEL, DEPTH, RWKV_WIDTH
    ch = jnp.linspace(0.0, 1.0, RW, dtype=jnp.float32)
    return {
        'x': nrm((BATCH, SEQ, D), 1.0),
        'c': nrm((BATCH, D), 1.0),
        'w_ada': nrm((L, D, 6 * D), 0.5 * D ** -0.5),
        'b_ada': nrm((L, 6 * D), 0.02),
        'g_pre_mix': 1.0 + nrm((L, D), 0.02),
        'g_post_mix': 1.0 + nrm((L, D), 0.02),
        'g_pre_ffn': 1.0 + nrm((L, D), 0.02),
        'g_post_ffn': 1.0 + nrm((L, D), 0.02),
        'w_in': nrm((L, D, N_IN), D ** -0.5),
        'gla_w_a_up': nrm((L, GLA_GATE_RANK, GLA_QK), GLA_GATE_RANK ** -0.5),
        'gla_b_a': 1.0 + nrm((L, GLA_QK), 0.5),
        'gla_norm_w': 1.0 + nrm((L, GLA_V), 0.02),
        'rwkv_mu': unif((L, RWKV_COLS)),
        'rwkv_w0': -6.5 + 5.0 * ch ** 0.85 + nrm((L, RW), 0.1),
        'rwkv_w_up': nrm((L, RWKV_W_RANK, RW), 0.5 * RWKV_W_RANK ** -0.5),
        'rwkv_a0': nrm((L, RW), 0.1),
        'rwkv_a_up': nrm((L, RWKV_A_RANK, RW), RWKV_A_RANK ** -0.5),
        'rwkv_g_up': nrm((L, RWKV_G_RANK, RW), RWKV_G_RANK ** -0.5),
        'rwkv_k_k': 0.85 + nrm((L, RW), 0.02),
        'rwkv_k_a': 1.0 + nrm((L, RW), 0.02),
        'rwkv_r_k': nrm((L, RWKV_HEADS, RWKV_HEAD), 0.1),
        'rwkv_gn_w': 1.0 + nrm((L, RW), 0.02),
        'rwkv_gn_b': nrm((L, RW), 0.02),
        'vres_w_down': nrm((L - 1, D, RWKV_V_RANK), D ** -0.5),
        'vres_mu': unif((L - 1, RWKV_V_RANK)),
        'vres_up': nrm((L - 1, RWKV_V_RANK, RW), RWKV_V_RANK ** -0.5),
        'vres_v0': 1.0 + nrm((L - 1, RW), 0.1),
        'w_out': nrm((L, D_MIX, D), D_MIX ** -0.5),
        'w_ff1': nrm((L, D, D_FF), D ** -0.5),
        'w_ff2': nrm((L, D_FF, D), D_FF ** -0.5),
    }


def reference(x, c, w_ada, b_ada, g_pre_mix, g_post_mix, g_pre_ffn, g_post_ffn, w_in,
              gla_w_a_up, gla_b_a, gla_norm_w, rwkv_mu, rwkv_w0, rwkv_w_up, rwkv_a0, rwkv_a_up,
              rwkv_g_up, rwkv_k_k, rwkv_k_a, rwkv_r_k, rwkv_gn_w, rwkv_gn_b, vres_w_down, vres_mu,
              vres_up, vres_v0, w_out, w_ff1, w_ff2):
    cond = jax.nn.silu(c)
    v_first = None
    for i in range(DEPTH):
        mod = cond @ w_ada[i] + b_ada[i]
        sh1, sc1, gt1, sh2, sc2, gt2 = (m[:, None, :] for m in jnp.split(mod, 6, axis=-1))

        h = rmsnorm(x, g_pre_mix[i]) * (1.0 + sc1) + sh1
        z = h @ w_in[i]
        z_gla = z[..., :GLA_COLS]
        z_rwkv = lerp_shift(z[..., GLA_COLS:], rwkv_mu[i])
        gq, gk, gv, gg, ga = split_cols(z_gla, GLA_SPLITS)
        rr, rk, rv, rw, ra, rg = split_cols(z_rwkv, RWKV_SPLITS)
        if i == 0:
            v_first = rv
        else:
            j = i - 1
            vl = lerp_shift(h @ vres_w_down[j], vres_mu[j])
            rv = rv + (v_first - rv) * jax.nn.sigmoid(vres_v0[j] + vl @ vres_up[j])
        o_gla = gla_mixer(gq, gk, gv, gg, ga, gla_w_a_up[i], gla_b_a[i], gla_norm_w[i])
        o_rwkv = rwkv7_mixer(rr, rk, rv, rw, ra, rg, rwkv_w0[i], rwkv_w_up[i], rwkv_a0[i], rwkv_a_up[i],
                             rwkv_g_up[i], rwkv_k_k[i], rwkv_k_a[i], rwkv_r_k[i], rwkv_gn_w[i], rwkv_gn_b[i])
        y = jnp.concatenate([o_gla, o_rwkv], axis=-1) @ w_out[i]
        x = x + gt1 * rmsnorm(y, g_post_mix[i])

        h = rmsnorm(x, g_pre_ffn[i]) * (1.0 + sc2) + sh2
        y = jnp.square(jax.nn.relu(h @ w_ff1[i])) @ w_ff2[i]
        x = x + gt2 * rmsnorm(y, g_post_ffn[i])
    return x
```

```cpp
#include <hip/hip_runtime.h>
#include <hip/hip_cooperative_groups.h>
#include <cstdio>
namespace cg = cooperative_groups;
__device__ __forceinline__ int launder_v(int x) { asm volatile("" : "+v"(x)); return x; }
__device__ __forceinline__ int launder_s(int x) { asm volatile("" : "+s"(x)); return x; }
__device__ __forceinline__ int lane_id_v() { int x; asm volatile("v_mbcnt_lo_u32_b32 %0, -1, 0\n\tv_mbcnt_hi_u32_b32 %0, -1, %0" : "=v"(x)); return x; }
#define TIDX (launder_s(wv_) * 64 + lane_id_v())
__device__ __forceinline__ unsigned char* launder_p(unsigned char* x) { asm volatile("" : "+s"(x)); return x; }
namespace pg8 {
#define PG8_LAS __attribute__((address_space(3)))
typedef unsigned short bf16_t;
typedef short bf16x8 __attribute__((ext_vector_type(8)));
typedef float f32x4 __attribute__((ext_vector_type(4)));
typedef unsigned u32x4 __attribute__((ext_vector_type(4)));
constexpr int BM = 256, BK = 64, HALF = 128, HTB = HALF * BK * 2  , STAGE_BYTES = 8 * HTB, NXCD = 8, WGM = 8;

__host__ __device__ __forceinline__ int lds_byte(int r, int c) { const int st = (r >> 4) * 2 + (c >> 5), rr = r & 15, cc = c & 31, ob = rr * 64 + cc * 2; return st * 1024 + (ob ^ (((ob >> 9) & 1) << 5)); }
__host__ __device__ __forceinline__ void stage_rc(int b, int& R, int& C) { const int st = b / 1024, sb = b % 1024, swz = sb ^ (((sb >> 9) & 1) << 5); R = (st >> 1) * 16 + swz / 64; C = (st & 1) * 32 + (swz % 64) / 2; }
__host__ __device__ __forceinline__ int perm32(int rho) { const int n = rho >> 4, i = rho & 15; return 8 * (i >> 2) + 4 * n + (i & 3); }

struct Unit { int pm, pn; };
struct Gemm { const bf16_t* A; const bf16_t* Bt; int M, N, K; };

struct StaticOrder {
    int nM, nN, nwg, G, c;
    __host__ __device__ void init(int M, int N, int G_, int c_) { nM = M / BM; nN = N / BM; nwg = nM * nN; G = G_; c = c_; }
    __host__ __device__ bool next(int i, Unit& u) const {
        const long L = (long)i * G + c; if (L >= nwg) return false;
        int wgid = (int)L; { const int q = nwg / NXCD, r = nwg % NXCD, xcd = wgid % NXCD, off = wgid / NXCD; wgid = (xcd < r ? xcd * (q + 1) : r * (q + 1) + (xcd - r) * q) + off; }
        const int nig = WGM * nN, gid = wgid / nig, fm = gid * WGM, gsz = (nM - fm) < WGM ? (nM - fm) : WGM;
        u.pm = fm + ((wgid % nig) % gsz); u.pn = (wgid % nig) / gsz; return true;
    }
    __device__ __forceinline__ void a_ready(const Unit&) const {}
    __device__ __forceinline__ void done(const Unit&) const {}
};
__device__ __forceinline__ unsigned cvt_pk_bf16(float lo, float hi) { unsigned r; asm volatile("v_cvt_pk_bf16_f32 %0, %1, %2" : "=v"(r) : "v"(lo), "v"(hi)); return r; }
template <class Epi, class Sched, bool STAMP = false>
__device__ __forceinline__ void gemm_phase(const int wv_, PG8_LAS unsigned char* lds, const Gemm g, const Sched& S, const Epi& E, unsigned long long* stamps) {
    const int tid = TIDX, wid = __builtin_amdgcn_readfirstlane(tid >> 6), lane = tid & 63, wr = wid >> 2, wc = wid & 3, fr = lane & 15, fq = lane >> 4;
    const int K = g.K, nt = K / BK;
    int ts_lo = 0, ts_hi = 0, nts = 0; const unsigned long long rt_entry = STAMP ? (unsigned long long)wall_clock64() : 0ull;
#define PG8_STAMP() do { if (STAMP && wid == 0 && nts < 64) { const unsigned long long _c = (unsigned long long)clock64(); \
        ts_lo = (lane == nts) ? (int)(unsigned)_c : ts_lo; ts_hi = (lane == nts) ? (int)(unsigned)(_c >> 32) : ts_hi; ++nts; } } while (0)
    PG8_STAMP();
    unsigned voffA[2], voffB[2];
#pragma unroll
    for (int i = 0; i < 2; ++i) { int R, C; stage_rc(tid * 16 + i * 8192, R, C); const int Rb = Epi::PERM ? ((R & ~31) + perm32(R & 31)) : R;
        voffA[i] = (unsigned)(R * K + C) * 2u; voffB[i] = (unsigned)(Rb * K + C) * 2u; }
    const size_t kstep = (size_t)(BK * 2);
    const size_t hstep = (size_t)HALF * K * 2;
    const size_t tstep = 2 * hstep;
    const unsigned ldsw = (unsigned)wid * 1024u;
    const int aoff = lds_byte(wr * 64 + fr, fq * 8), boff = lds_byte(wc * 32 + fr, fq * 8);
#define PG8_SA(b, h) (((b) * 2 + (h)) * HTB)
#define PG8_SB(b, h) ((4 + (b) * 2 + (h)) * HTB)
#define PG8_STAGE(bufoff, gbase, voff) do { _Pragma("unroll") for (int _i = 0; _i < 2; ++_i) \
        __builtin_amdgcn_global_load_lds((const unsigned*)((const char*)(gbase) + (voff)[_i]), (PG8_LAS unsigned*)(lds + (bufoff) + ldsw + _i * 8192), 16, 0, 0); } while (0)
#define PG8_LDA(dst, b, h) do { _Pragma("unroll") for (int m = 0; m < 4; ++m) _Pragma("unroll") for (int k = 0; k < 2; ++k) dst[m][k] = *(const PG8_LAS bf16x8*)(lds + PG8_SA(b, h) + aoff + m * 2048 + k * 1024); } while (0)
#define PG8_LDB(dst, b, h) do { _Pragma("unroll") for (int n = 0; n < 2; ++n) _Pragma("unroll") for (int k = 0; k < 2; ++k) dst[n][k] = *(const PG8_LAS bf16x8*)(lds + PG8_SB(b, h) + boff + n * 2048 + k * 1024); } while (0)
#define PG8_MMA(ai, bj, At, Bt) do { __builtin_amdgcn_s_setprio(1); _Pragma("unroll") for (int m = 0; m < 4; ++m) _Pragma("unroll") for (int n = 0; n < 2; ++n) _Pragma("unroll") for (int k = 0; k < 2; ++k) \
        acc[ai][bj][m][n] = __builtin_amdgcn_mfma_f32_16x16x32_bf16(Bt[n][k], At[m][k], acc[ai][bj][m][n], 0, 0, 0); __builtin_amdgcn_s_setprio(0); } while (0)
#define PG8_WAIT_V(n) asm volatile("s_waitcnt vmcnt(" #n ")" ::: "memory")
#define PG8_WAIT_L(n) asm volatile("s_waitcnt lgkmcnt(" #n ")" ::: "memory")
#define PG8_BAR __builtin_amdgcn_s_barrier()
#define PG8_SCHED __builtin_amdgcn_sched_barrier(0)
    Unit cur, nxt; int ui = 0;
    if (!S.next(0, cur)) return;
    f32x4 acc[2][2][4][2];
#pragma unroll
    for (int a = 0; a < 2; ++a)
#pragma unroll
        for (int b = 0; b < 2; ++b)
#pragma unroll
            for (int m = 0; m < 4; ++m)
#pragma unroll
                for (int n = 0; n < 2; ++n) acc[a][b][m][n] = (f32x4){0.f, 0.f, 0.f, 0.f};
    bf16x8 At[4][2], B0[2][2], B1[2][2];
    const char* cA = (const char*)g.A + (size_t)cur.pm * tstep; const char* cB = (const char*)g.Bt + (size_t)cur.pn * tstep;
    S.a_ready(cur);
    PG8_STAGE(PG8_SB(0, 0), cB, voffB); PG8_STAGE(PG8_SA(0, 0), cA, voffA); PG8_STAGE(PG8_SB(0, 1), cB + hstep, voffB); PG8_STAGE(PG8_SA(0, 1), cA + hstep, voffA);
    if (wr == 1) PG8_BAR;
    PG8_WAIT_V(4); PG8_BAR;
    PG8_STAGE(PG8_SB(1, 0), cB + kstep, voffB); PG8_STAGE(PG8_SA(1, 0), cA + kstep, voffA); PG8_STAGE(PG8_SB(1, 1), cB + hstep + kstep, voffB);
    PG8_WAIT_V(6); PG8_BAR;
    PG8_STAMP();
    for (;;) {
        const bool has_next = S.next(ui + 1, nxt);
        const char* nA = has_next ? (const char*)g.A + (size_t)nxt.pm * tstep : cA; const char* nB = has_next ? (const char*)g.Bt + (size_t)nxt.pn * tstep : cB;
        for (int t = 0; t < nt; t += 2) {
            const bool last = (t == nt - 2);
            const char* a1 = cA + (size_t)(t + 1) * kstep;
            const char* a2 = last ? nA : cA + (size_t)(t + 2) * kstep; const char* b2 = last ? nB : cB + (size_t)(t + 2) * kstep;
            const char* a3 = a2 + kstep; const char* b3 = b2 + kstep;
            if (last && has_next) S.a_ready(nxt);
            PG8_LDB(B0, 0, 0); PG8_SCHED; PG8_LDA(At, 0, 0); PG8_STAGE(PG8_SA(1, 1), a1 + hstep, voffA);
            PG8_WAIT_L(8); PG8_BAR; PG8_WAIT_L(0); PG8_MMA(0, 0, At, B0); PG8_BAR; PG8_SCHED;
            PG8_LDB(B1, 0, 1); PG8_STAGE(PG8_SB(0, 0), b2, voffB);
            PG8_BAR; PG8_WAIT_L(0); PG8_MMA(0, 1, At, B1); PG8_BAR;
            PG8_LDA(At, 0, 1); PG8_STAGE(PG8_SA(0, 0), a2, voffA);
            PG8_BAR; PG8_WAIT_L(0); PG8_MMA(1, 0, At, B0); PG8_BAR; PG8_SCHED;
            PG8_STAGE(PG8_SB(0, 1), b2 + hstep, voffB);
            PG8_WAIT_V(6); PG8_BAR; PG8_MMA(1, 1, At, B1); PG8_BAR;
            PG8_LDB(B0, 1, 0); PG8_SCHED; PG8_LDA(At, 1, 0); PG8_STAGE(PG8_SA(0, 1), a2 + hstep, voffA);
            PG8_WAIT_L(8); PG8_BAR; PG8_WAIT_L(0); PG8_MMA(0, 0, At, B0); PG8_BAR; PG8_SCHED;
            PG8_LDB(B1, 1, 1); PG8_STAGE(PG8_SB(1, 0), b3, voffB);
            PG8_BAR; PG8_WAIT_L(0); PG8_MMA(0, 1, At, B1); PG8_BAR;
            PG8_LDA(At, 1, 1); PG8_STAGE(PG8_SA(1, 0), a3, voffA);
            PG8_BAR; PG8_WAIT_L(0); PG8_MMA(1, 0, At, B0); PG8_BAR; PG8_SCHED;
            PG8_STAGE(PG8_SB(1, 1), b3 + hstep, voffB);
            PG8_WAIT_V(6); PG8_BAR; PG8_MMA(1, 1, At, B1); PG8_BAR;
        }
        PG8_STAMP();
        if constexpr (!Epi::AFTER_DRAIN) { E(acc, cur, wr, wc, fr, fq); S.done(cur); }
        PG8_STAMP();
        if (!has_next) break;
#pragma unroll
        for (int a = 0; a < 2; ++a)
#pragma unroll
            for (int b = 0; b < 2; ++b)
#pragma unroll
                for (int m = 0; m < 4; ++m)
#pragma unroll
                    for (int n = 0; n < 2; ++n) acc[a][b][m][n] = (f32x4){0.f, 0.f, 0.f, 0.f};
        cur = nxt; cA = nA; cB = nB; ++ui;
    }
    PG8_WAIT_V(0);
    if (wr == 0) PG8_BAR;
    PG8_BAR;
    if constexpr (Epi::AFTER_DRAIN) { E.fused(acc, cur, wr, wc, fr, fq, lds, wid, lane); S.done(cur); }
    PG8_STAMP();
    if (STAMP && wid == 0) { stamps[lane] = lane < nts ? (((unsigned long long)(unsigned)ts_hi << 32) | (unsigned)ts_lo) : 0ull;
        if (lane == 62) stamps[62] = rt_entry; if (lane == 63) stamps[63] = (unsigned long long)wall_clock64(); }
#undef PG8_STAMP
#undef PG8_SA
#undef PG8_SB
#undef PG8_STAGE
#undef PG8_LDA
#undef PG8_LDB
#undef PG8_MMA
#undef PG8_WAIT_V
#undef PG8_WAIT_L
#undef PG8_BAR
#undef PG8_SCHED
}
}
typedef unsigned short u16;
typedef float f4 __attribute__((ext_vector_type(4)));
typedef float f2 __attribute__((ext_vector_type(2)));
typedef unsigned u32x2 __attribute__((ext_vector_type(2)));
typedef unsigned u32x4 __attribute__((ext_vector_type(4)));
using pg8::f32x4;
constexpr int T = 8192, D = 2048, DFF = 8192;
constexpr int NG = 3328, NR = 3584, NINP = 6912;
constexpr size_t MiB = 1048576;
constexpr size_t WS_WIN = 0, WS_WOUT = 27 * MiB, WS_WFF1 = 35 * MiB, WS_WFF2 = 67 * MiB, WS_LRT = 99 * MiB, WS_GUPT = 101 * MiB, WS_MOD = 102 * MiB,
                 WS_ACAT1 = 103 * MiB, WS_ACAT2 = 107 * MiB, WS_HA = 112 * MiB, WS_Y = 144 * MiB, WS_YR = 144 * MiB, WS_OG = 176 * MiB,
                 WS_ZG = 208 * MiB, WS_ZR = 312 * MiB, WS_NB = 312 * MiB, WS_MB = 328 * MiB, WS_SB = 344 * MiB, WS_NGB = 360 * MiB, WS_SGB = 376 * MiB, WS_PGB = 392 * MiB,
                 WS_U = 208 * MiB, WS_V0 = 424 * MiB, WS_W = 456 * MiB, WS_A = 488 * MiB, WS_B = 520 * MiB, WS_K = 552 * MiB, WS_R = 584 * MiB, WS_V1 = 616 * MiB,
                 WS_GATE = 648 * MiB, WS_ALPHA = 680 * MiB, WS_CTL = 696 * MiB, WS_END = 697 * MiB;

struct Params { const float* in[30]; float* out; unsigned char* ws; };

__device__ __forceinline__ unsigned pk_bf16(float lo, float hi) { return pg8::cvt_pk_bf16(lo, hi); }
__device__ __forceinline__ u16 to_bf16(float v) { return (u16)(pk_bf16(v, 0.f) & 0xffffu); }
__device__ __forceinline__ float sigm(float x) { return 1.0f / (1.0f + __expf(-x)); }
__device__ __forceinline__ float wave_sum(float v) { v += __shfl_xor(v, 32); v += __shfl_xor(v, 16); v += __shfl_xor(v, 8); v += __shfl_xor(v, 4); v += __shfl_xor(v, 2); v += __shfl_xor(v, 1); return v; }
__device__ __forceinline__ float half_sum(float v) { v += __shfl_xor(v, 16); v += __shfl_xor(v, 8); v += __shfl_xor(v, 4); v += __shfl_xor(v, 2); v += __shfl_xor(v, 1); return v; }
template <int CTRL> __device__ __forceinline__ float dppf(float x) { return __builtin_bit_cast(float, __builtin_amdgcn_mov_dpp(__builtin_bit_cast(int, x), CTRL, 0xf, 0xf, true)); }
__device__ __forceinline__ float red8(float x) { x += dppf<0xB1>(x); x += dppf<0x4E>(x); x += dppf<0x141>(x); return x; }

__device__ __forceinline__ void grid_bar(const int wv_, unsigned char* wsraw, unsigned& target) {
    unsigned* ctr = (unsigned*)(launder_p(wsraw) + WS_CTL);
    target += gridDim.x;
    __builtin_amdgcn_fence(__ATOMIC_RELEASE, "agent");
    __syncthreads();
    if (TIDX == 0) {
        __hip_atomic_fetch_add(ctr, 1u, __ATOMIC_RELAXED, __HIP_MEMORY_SCOPE_AGENT);
        while (__hip_atomic_load(ctr, __ATOMIC_RELAXED, __HIP_MEMORY_SCOPE_AGENT) < target) __builtin_amdgcn_s_sleep(2);
    }
    __syncthreads();
    __builtin_amdgcn_fence(__ATOMIC_ACQUIRE, "agent");
}
struct ConvJob { const float* src; int src_ld; u16* dst; int dst_ld; int nrows, nk; };
constexpr int NJOBS = 15;
__device__ __forceinline__ ConvJob conv_job(const Params& p, int L, int j) {
    unsigned char* ws = launder_p(p.ws);
    u16* WinT = (u16*)(ws + WS_WIN); u16* WoutT = (u16*)(ws + WS_WOUT); u16* Wff1T = (u16*)(ws + WS_WFF1); u16* Wff2T = (u16*)(ws + WS_WFF2);
    u16* LrT = (u16*)(ws + WS_LRT); u16* GupT = (u16*)(ws + WS_GUPT);
    ConvJob J; J.src = nullptr; J.src_ld = 0; J.dst = WinT; J.dst_ld = 2048; J.nrows = 0; J.nk = 0;
    if (j == 0)       { J.src = p.in[8] + (size_t)L * 2048 * 6608;        J.src_ld = 6608; J.dst = WinT;                       J.dst_ld = 2048; J.nrows = 3088; J.nk = 2048; }
    else if (j == 1)  {                                                                    J.dst = WinT + (size_t)3088 * 2048; J.dst_ld = 2048; J.nrows = 240;  J.nk = 2048; }
    else if (j == 2)  { J.src = p.in[8] + (size_t)L * 2048 * 6608 + 3088; J.src_ld = 6608; J.dst = WinT + (size_t)3328 * 2048; J.dst_ld = 2048; J.nrows = 3520; J.nk = 2048; }
    else if (j == 3)  { J.src = (L == 1) ? p.in[23] : nullptr;            J.src_ld = 64;   J.dst = WinT + (size_t)6848 * 2048; J.dst_ld = 2048; J.nrows = 64;   J.nk = 2048; }
    else if (j == 4)  { J.src = p.in[27] + (size_t)L * 2048 * 2048;       J.src_ld = 2048; J.dst = WoutT;                      J.dst_ld = 2048; J.nrows = 2048; J.nk = 2048; }
    else if (j == 5)  { J.src = p.in[28] + (size_t)L * 2048 * 8192;       J.src_ld = 8192; J.dst = Wff1T;                      J.dst_ld = 2048; J.nrows = 8192; J.nk = 2048; }
    else if (j == 6)  { J.src = p.in[29] + (size_t)L * 8192 * 2048;       J.src_ld = 2048; J.dst = Wff2T;                      J.dst_ld = 8192; J.nrows = 2048; J.nk = 8192; }
    else if (j == 7)  { J.src = p.in[14] + (size_t)L * 96 * 1024;         J.src_ld = 1024; J.dst = LrT;                        J.dst_ld = 256;  J.nrows = 1024; J.nk = 96; }
    else if (j == 8)  {                                                                    J.dst = LrT + 96;                   J.dst_ld = 256;  J.nrows = 1024; J.nk = 160; }
    else if (j == 9)  {                                                                    J.dst = LrT + 1024 * 256;           J.dst_ld = 256;  J.nrows = 1024; J.nk = 96; }
    else if (j == 10) { J.src = p.in[16] + (size_t)L * 96 * 1024;         J.src_ld = 1024; J.dst = LrT + 1024 * 256 + 96;      J.dst_ld = 256;  J.nrows = 1024; J.nk = 96; }
    else if (j == 11) {                                                                    J.dst = LrT + 1024 * 256 + 192;     J.dst_ld = 256;  J.nrows = 1024; J.nk = 64; }
    else if (j == 12) {                                                                    J.dst = LrT + 2048 * 256;           J.dst_ld = 256;  J.nrows = 1024; J.nk = 192; }
    else if (j == 13) { J.src = (L == 1) ? p.in[25] : nullptr;            J.src_ld = 1024; J.dst = LrT + 2048 * 256 + 192;     J.dst_ld = 256;  J.nrows = 1024; J.nk = 64; }
    else              { J.src = p.in[17] + (size_t)L * 256 * 1024;        J.src_ld = 1024; J.dst = GupT;                       J.dst_ld = 256;  J.nrows = 1024; J.nk = 256; }
    return J;
}
__device__ __forceinline__ void phase_conv(const int wv_, const Params& p, int L, float* tile) {
    const int tid = TIDX;
    int total = 0;
    for (int j = 0; j < NJOBS; ++j) { const ConvJob J = conv_job(p, L, j); total += ((J.nrows + 63) >> 6) * ((J.nk + 63) >> 6); }
    for (int g = blockIdx.x; g < total; g += gridDim.x) {
        int rem = g, jj = 0; ConvJob J = conv_job(p, L, 0);
        for (;;) { const int cnt = ((J.nrows + 63) >> 6) * ((J.nk + 63) >> 6); if (rem < cnt) break; rem -= cnt; ++jj; J = conv_job(p, L, jj); }
        const int ntn = (J.nrows + 63) >> 6; const int tn = rem % ntn, tk = rem / ntn; const int n0 = tn * 64, k0 = tk * 64;
        { const int nl = tid & 63, ks = tid >> 6; const bool okn = (n0 + nl) < J.nrows;
#pragma unroll
          for (int kk = 0; kk < 8; ++kk) { const int k = ks * 8 + kk; float v = 0.f;
              if (J.src != nullptr && okn && (k0 + k) < J.nk) v = J.src[(size_t)(k0 + k) * J.src_ld + n0 + nl];
              tile[k * 65 + nl] = v; } }
        __syncthreads();
        { const int nr = tid >> 3, kc = (tid & 7) * 8;
          if ((n0 + nr) < J.nrows && (k0 + kc) < J.nk) { u32x4 w;
              w.x = pk_bf16(tile[(kc + 0) * 65 + nr], tile[(kc + 1) * 65 + nr]); w.y = pk_bf16(tile[(kc + 2) * 65 + nr], tile[(kc + 3) * 65 + nr]);
              w.z = pk_bf16(tile[(kc + 4) * 65 + nr], tile[(kc + 5) * 65 + nr]); w.w = pk_bf16(tile[(kc + 6) * 65 + nr], tile[(kc + 7) * 65 + nr]);
              *(u32x4*)(J.dst + (size_t)(n0 + nr) * J.dst_ld + k0 + kc) = w; } }
        __syncthreads();
    }
}
__device__ __forceinline__ void phase_ada(const int wv_, const Params& p, float* ldsf) {
    const float* c = p.in[1]; float* mod = (float*)(p.ws + WS_MOD);
    const int tid = TIDX, c4 = tid & 31, kg = tid >> 5;
    for (int task = blockIdx.x; task < 192; task += gridDim.x) {
        const int L = task / 96, cb = task % 96;
        const float* W = p.in[2] + (size_t)L * 2048 * 12288 + cb * 128 + c4 * 4;
        f4 acc = (f4){0.f, 0.f, 0.f, 0.f};
#pragma unroll 8
        for (int k = kg; k < 2048; k += 16) { const float cv = c[k]; const float s = cv / (1.0f + __expf(-cv)); const f4 w = *(const f4*)(W + (size_t)k * 12288); acc += s * w; }
        *(f4*)(ldsf + kg * 128 + c4 * 4) = acc;
        __syncthreads();
        if (tid < 128) { float s = 0.f; for (int g2 = 0; g2 < 16; ++g2) s += ldsf[g2 * 128 + tid]; mod[L * 12288 + cb * 128 + tid] = s + p.in[3][L * 12288 + cb * 128 + tid]; }
        __syncthreads();
    }
}
__device__ __forceinline__ void phase_rowwise(const int wv_, const float* xin, const float* y, const float* gt, const float* gpost, float* xout,
                                              const float* gpre, const float* sc, const float* sh, u16* hout) {
    const int lane = TIDX & 63, wave = TIDX >> 6;
    for (int row = blockIdx.x * 8 + wave; row < T; row += gridDim.x * 8) {
        f4 xv[8];
#pragma unroll
        for (int i = 0; i < 8; ++i) xv[i] = *(const f4*)(xin + (size_t)row * D + i * 256 + lane * 4);
        if (y != nullptr) {
            f4 yv[8]; float ss = 0.f;
#pragma unroll
            for (int i = 0; i < 8; ++i) { yv[i] = *(const f4*)(y + (size_t)row * D + i * 256 + lane * 4); ss += yv[i][0] * yv[i][0] + yv[i][1] * yv[i][1] + yv[i][2] * yv[i][2] + yv[i][3] * yv[i][3]; }
            ss = wave_sum(ss); const float rs = rsqrtf(ss * (1.0f / 2048.0f) + 1e-6f);
#pragma unroll
            for (int i = 0; i < 8; ++i) { const f4 g = *(const f4*)(gpost + i * 256 + lane * 4), tt = *(const f4*)(gt + i * 256 + lane * 4); xv[i] += tt * ((yv[i] * rs) * g); }
        }
        if (xout != nullptr) {
#pragma unroll
            for (int i = 0; i < 8; ++i) *(f4*)(xout + (size_t)row * D + i * 256 + lane * 4) = xv[i];
        }
        if (hout != nullptr) {
            float ss = 0.f;
#pragma unroll
            for (int i = 0; i < 8; ++i) ss += xv[i][0] * xv[i][0] + xv[i][1] * xv[i][1] + xv[i][2] * xv[i][2] + xv[i][3] * xv[i][3];
            ss = wave_sum(ss); const float rs = rsqrtf(ss * (1.0f / 2048.0f) + 1e-6f);
#pragma unroll
            for (int i = 0; i < 8; ++i) { const f4 g = *(const f4*)(gpre + i * 256 + lane * 4), s1 = *(const f4*)(sc + i * 256 + lane * 4), s0 = *(const f4*)(sh + i * 256 + lane * 4);
                const f4 h = ((xv[i] * rs) * g) * (1.0f + s1) + s0; u32x2 w; w.x = pk_bf16(h[0], h[1]); w.y = pk_bf16(h[2], h[3]);
                *(u32x2*)(hout + (size_t)row * D + i * 256 + lane * 4) = w; }
        }
    }
}
struct EpiZ { static constexpr bool PERM = false, AFTER_DRAIN = false; float* zG; float* zR;
    __device__ __forceinline__ void operator()(const f32x4 (&acc)[2][2][4][2], const pg8::Unit& u, int wr, int wc, int fr, int fq) const {
        float* base; int ld, ct; if (u.pn < 13) { base = zG; ld = NG; ct = u.pn; } else { base = zR; ld = NR; ct = u.pn - 13; }
        const int row0 = u.pm * 256 + wr * 64 + fr, col0 = ct * 256 + wc * 32 + 4 * fq;
#pragma unroll
        for (int ai = 0; ai < 2; ++ai)
#pragma unroll
            for (int m = 0; m < 4; ++m) { float* rowp = base + (size_t)(row0 + ai * 128 + m * 16) * ld + col0;
#pragma unroll
                for (int bj = 0; bj < 2; ++bj)
#pragma unroll
                    for (int n = 0; n < 2; ++n) *(f32x4*)(rowp + bj * 128 + n * 16) = acc[ai][bj][m][n]; }
    } };
struct EpiPlain { static constexpr bool PERM = false, AFTER_DRAIN = false; float* C; int ldc;
    __device__ __forceinline__ void operator()(const f32x4 (&acc)[2][2][4][2], const pg8::Unit& u, int wr, int wc, int fr, int fq) const {
        const int row0 = u.pm * 256 + wr * 64 + fr, col0 = u.pn * 256 + wc * 32 + 4 * fq;
#pragma unroll
        for (int ai = 0; ai < 2; ++ai)
#pragma unroll
            for (int m = 0; m < 4; ++m) { float* rowp = C + (size_t)(row0 + ai * 128 + m * 16) * ldc + col0;
#pragma unroll
                for (int bj = 0; bj < 2; ++bj)
#pragma unroll
                    for (int n = 0; n < 2; ++n) *(f32x4*)(rowp + bj * 128 + n * 16) = acc[ai][bj][m][n]; }
    } };
struct EpiRelu2 { static constexpr bool PERM = false, AFTER_DRAIN = false; u16* O; int ldc;
    __device__ __forceinline__ void operator()(const f32x4 (&acc)[2][2][4][2], const pg8::Unit& u, int wr, int wc, int fr, int fq) const {
        const int row0 = u.pm * 256 + wr * 64 + fr, col0 = u.pn * 256 + wc * 32 + 4 * fq;
#pragma unroll
        for (int ai = 0; ai < 2; ++ai)
#pragma unroll
            for (int m = 0; m < 4; ++m) { u16* rowp = O + (size_t)(row0 + ai * 128 + m * 16) * ldc + col0;
#pragma unroll
                for (int bj = 0; bj < 2; ++bj)
#pragma unroll
                    for (int n = 0; n < 2; ++n) { f32x4 v = acc[ai][bj][m][n];
                        v[0] = fmaxf(v[0], 0.f); v[1] = fmaxf(v[1], 0.f); v[2] = fmaxf(v[2], 0.f); v[3] = fmaxf(v[3], 0.f); v = v * v;
                        u32x2 w; w.x = pk_bf16(v[0], v[1]); w.y = pk_bf16(v[2], v[3]); *(u32x2*)(rowp + bj * 128 + n * 16) = w; } }
    } };
#define EPI_LOOP_BEGIN const int row0 = u.pm * 256 + wr * 64 + fr, col0 = u.pn * 256 + wc * 32 + 4 * fq; \
        _Pragma("unroll") for (int ai = 0; ai < 2; ++ai) _Pragma("unroll") for (int m = 0; m < 4; ++m) { _Pragma("unroll") for (int bj = 0; bj < 2; ++bj) _Pragma("unroll") for (int n = 0; n < 2; ++n) { \
            const int cl = col0 + bj * 128 + n * 16; const size_t idx = (size_t)(row0 + ai * 128 + m * 16) * 1024 + cl; const f32x4 a = acc[ai][bj][m][n];
#define EPI_LOOP_END } asm volatile("" ::: "memory"); }
struct EpiW { static constexpr bool PERM = false, AFTER_DRAIN = false; float* W; const float* w0;
    __device__ __forceinline__ void operator()(const f32x4 (&acc)[2][2][4][2], const pg8::Unit& u, int wr, int wc, int fr, int fq) const {
        EPI_LOOP_BEGIN
            const f32x4 b0 = *(const f32x4*)(w0 + cl); f32x4 o;
#pragma unroll
            for (int q = 0; q < 4; ++q) o[q] = __expf(-0.60653065971f * sigm(b0[q] + a[q]));
            *(f32x4*)(W + idx) = o;
        EPI_LOOP_END
    } };
struct EpiA { static constexpr bool PERM = false, AFTER_DRAIN = false; float* B; float* K; const float* a0; const float* k_a;
    __device__ __forceinline__ void operator()(const f32x4 (&acc)[2][2][4][2], const pg8::Unit& u, int wr, int wc, int fr, int fq) const {
        EPI_LOOP_BEGIN
            const f32x4 b0 = *(const f32x4*)(a0 + cl), ka = *(const f32x4*)(k_a + cl); f32x4 bv = *(const f32x4*)(B + idx), kv = *(const f32x4*)(K + idx);
#pragma unroll
            for (int q = 0; q < 4; ++q) { const float alr = sigm(b0[q] + a[q]); bv[q] *= alr; kv[q] *= (1.0f + (alr - 1.0f) * ka[q]); }
            *(f32x4*)(B + idx) = bv; *(f32x4*)(K + idx) = kv;
        EPI_LOOP_END
    } };
struct EpiV { static constexpr bool PERM = false, AFTER_DRAIN = false; float* V1; const float* V0; const float* v0;
    __device__ __forceinline__ void operator()(const f32x4 (&acc)[2][2][4][2], const pg8::Unit& u, int wr, int wc, int fr, int fq) const {
        EPI_LOOP_BEGIN
            const f32x4 b0 = *(const f32x4*)(v0 + cl), vr = *(const f32x4*)(V1 + idx), vf = *(const f32x4*)(V0 + idx); f32x4 o;
#pragma unroll
            for (int q = 0; q < 4; ++q) o[q] = vr[q] + (vf[q] - vr[q]) * sigm(b0[q] + a[q]);
            *(f32x4*)(V1 + idx) = o;
        EPI_LOOP_END
    } };
__device__ __forceinline__ void phase_prep(const int wv_, const Params& p, int L) {
    const int tid = TIDX;
    unsigned char* ws = launder_p(p.ws);
    const float* zG = (const float*)(ws + WS_ZG); const float* zR = (const float*)(ws + WS_ZR);
    float* R = (float*)(ws + WS_R); float* K = (float*)(ws + WS_K); float* A = (float*)(ws + WS_A); float* B = (float*)(ws + WS_B);
    float* Vd = (float*)(ws + (L == 0 ? WS_V0 : WS_V1)); float* ALPHA = (float*)(ws + WS_ALPHA);
    u16* Acat1 = (u16*)(ws + WS_ACAT1); u16* Acat2 = (u16*)(ws + WS_ACAT2);
    float mu[7];
#pragma unroll
    for (int m = 0; m < 7; ++m) { const int c = tid + 512 * m; mu[m] = (c < 3520) ? p.in[12][L * 3520 + c] : (L == 1 ? p.in[24][c - 3520] : 0.f); }
    const float kkw0 = p.in[18][L * 1024 + tid], kkw1 = p.in[18][L * 1024 + 512 + tid];
    float wa[16];
#pragma unroll
    for (int r = 0; r < 16; ++r) wa[r] = p.in[9][(size_t)L * 16 * 512 + r * 512 + tid];
    const float ba = p.in[10][L * 512 + tid];
    for (int tile = blockIdx.x; tile < T / 32; tile += gridDim.x) {
        const int t0 = tile * 32;
        float prev[7];
#pragma unroll
        for (int m = 0; m < 7; ++m) prev[m] = (t0 > 0) ? zR[(size_t)(t0 - 1) * NR + tid + 512 * m] : 0.f;
#pragma unroll 2
        for (int t = t0; t < t0 + 32; ++t) {
            float zl[7];
#pragma unroll
            for (int m = 0; m < 7; ++m) { const float cur = zR[(size_t)t * NR + tid + 512 * m]; zl[m] = cur + mu[m] * (prev[m] - cur); prev[m] = cur; }
            const size_t o = (size_t)t * 1024 + tid;
            R[o] = zl[0]; R[o + 512] = zl[1];
#pragma unroll
            for (int q = 0; q < 2; ++q) { const float kr = zl[2 + q]; const float kkv = kr * (q ? kkw1 : kkw0); const float ss = wave_sum(kkv * kkv);
                const float kn = kkv * rsqrtf(fmaxf(ss, 1e-24f)); K[o + 512 * q] = kr; A[o + 512 * q] = -kn; B[o + 512 * q] = kn; }
            Vd[o] = zl[4]; Vd[o + 512] = zl[5];
            { const float v6 = zl[6];
              if (tid < 96) Acat1[(size_t)t * 256 + tid] = to_bf16(tanhf(v6));
              else if (tid < 192) Acat1[(size_t)t * 256 + tid] = to_bf16(v6);
              else if (tid < 448) Acat2[(size_t)t * 256 + tid - 192] = to_bf16(sigm(v6));
              else Acat1[(size_t)t * 256 + 192 + tid - 448] = to_bf16(L == 1 ? v6 : 0.f); }
            { float acc = ba;
#pragma unroll
              for (int r = 0; r < 16; ++r) acc += zG[(size_t)t * NG + 3072 + r] * wa[r];
              const float ls = fminf(acc, 0.f) - log1pf(expf(-fabsf(acc)));
              ALPHA[(size_t)t * 512 + tid] = expf(ls * (1.0f / 16.0f)); }
        }
    }
}
struct ScanSrc { const float* b0; const float* b1; const float* b2; const float* b3; const float* b4; const float* b5; int ld0, ld1, ld2, ld3, ld4, ld5; };
template <bool RW, bool WY>
__device__ __forceinline__ void scan_run(const int wv_, float* ldsw, const ScanSrc& S, int t0, int nsteps, f2 (&s)[8][4], f2 (&pd)[4], float vks, float* yout, int ldy, float yscale) {
    const int lane = TIDX & 63, j = lane & 7, g = lane >> 3, lrow = lane >> 4, lcol = (lane & 15) * 4;
    f4 pre0, pre1, pre2, pre3, pre4, pre5;
#define SCAN_LOAD(tb) do { const size_t rr = (size_t)((tb) + lrow); \
        pre0 = *(const f4*)(S.b0 + rr * S.ld0 + lcol); pre3 = *(const f4*)(S.b3 + rr * S.ld3 + lcol); pre5 = *(const f4*)(S.b5 + rr * S.ld5 + lcol); \
        if (WY) pre4 = *(const f4*)(S.b4 + rr * S.ld4 + lcol); \
        if (RW) { pre1 = *(const f4*)(S.b1 + rr * S.ld1 + lcol); pre2 = *(const f4*)(S.b2 + rr * S.ld2 + lcol); } } while (0)
    const int nblk = nsteps >> 2;
    SCAN_LOAD(t0);
#pragma unroll 1
    for (int blk = 0; blk < nblk; ++blk) {
        __syncthreads();
        { float* d = ldsw + lrow * 64 + lcol;
            *(f4*)(d + 0 * 256) = pre0; *(f4*)(d + 3 * 256) = pre3; *(f4*)(d + 5 * 256) = pre5;
            if (WY) *(f4*)(d + 4 * 256) = pre4;
            if (RW) { *(f4*)(d + 1 * 256) = pre1; *(f4*)(d + 2 * 256) = pre2; } }
        __syncthreads();
        if (blk + 1 < nblk) SCAN_LOAD(t0 + (blk + 1) * 4);
#pragma unroll 1
        for (int st = 0; st < 4; ++st) {
            const float* Lp = ldsw + st * 64;
            const f4 wA = *(const f4*)(Lp + 0 * 256 + j * 8), wB = *(const f4*)(Lp + 0 * 256 + j * 8 + 4);
            const f4 kA = *(const f4*)(Lp + 3 * 256 + j * 8), kB = *(const f4*)(Lp + 3 * 256 + j * 8 + 4);
            const f4 vA = *(const f4*)(Lp + 5 * 256 + g * 8), vB = *(const f4*)(Lp + 5 * 256 + g * 8 + 4);
            f4 aA, aB, bA, bB, rA, rB;
            if (RW) { aA = *(const f4*)(Lp + 1 * 256 + j * 8); aB = *(const f4*)(Lp + 1 * 256 + j * 8 + 4); bA = *(const f4*)(Lp + 2 * 256 + j * 8); bB = *(const f4*)(Lp + 2 * 256 + j * 8 + 4); }
            if (WY) { rA = *(const f4*)(Lp + 4 * 256 + j * 8); rB = *(const f4*)(Lp + 4 * 256 + j * 8 + 4); }
            const f2 w2[4] = {(f2){wA[0], wA[1]}, (f2){wA[2], wA[3]}, (f2){wB[0], wB[1]}, (f2){wB[2], wB[3]}};
            const f2 k2[4] = {(f2){kA[0], kA[1]}, (f2){kA[2], kA[3]}, (f2){kB[0], kB[1]}, (f2){kB[2], kB[3]}};
            f2 a2[4], b2[4], r2[4];
            if (RW) { a2[0] = (f2){aA[0], aA[1]}; a2[1] = (f2){aA[2], aA[3]}; a2[2] = (f2){aB[0], aB[1]}; a2[3] = (f2){aB[2], aB[3]};
                      b2[0] = (f2){bA[0], bA[1]}; b2[1] = (f2){bA[2], bA[3]}; b2[2] = (f2){bB[0], bB[1]}; b2[3] = (f2){bB[2], bB[3]}; }
            if (WY) { r2[0] = (f2){rA[0], rA[1]}; r2[1] = (f2){rA[2], rA[3]}; r2[2] = (f2){rB[0], rB[1]}; r2[3] = (f2){rB[2], rB[3]}; }
            const float vv[8] = {vA[0], vA[1], vA[2], vA[3], vB[0], vB[1], vB[2], vB[3]};
            float ysel = 0.f;
#pragma unroll
            for (int i = 0; i < 8; ++i) {
                const float vi = vv[i] * vks;
                if (RW) {
                    f2 d2 = s[i][0] * a2[0]; d2 += s[i][1] * a2[1]; d2 += s[i][2] * a2[2]; d2 += s[i][3] * a2[3];
                    const float d = red8(d2[0] + d2[1]);
#pragma unroll
                    for (int q = 0; q < 4; ++q) s[i][q] = s[i][q] * w2[q] + (d * b2[q] + vi * k2[q]);
                } else {
#pragma unroll
                    for (int q = 0; q < 4; ++q) s[i][q] = s[i][q] * w2[q] + vi * k2[q];
                }
                if (WY) { f2 y2 = s[i][0] * r2[0]; y2 += s[i][1] * r2[1]; y2 += s[i][2] * r2[2]; y2 += s[i][3] * r2[3];
                    const float y = red8(y2[0] + y2[1]); ysel = (j == i) ? y : ysel; }
            }
            if (!RW) {
#pragma unroll
                for (int q = 0; q < 4; ++q) pd[q] *= w2[q];
            }
            if (WY) yout[(size_t)(t0 + blk * 4 + st) * ldy + lane] = ysel * yscale;
        }
    }
#undef SCAN_LOAD
}
__device__ __forceinline__ ScanSrc rwkv_src(unsigned char* ws, int L, int h) {
    ScanSrc S; S.b0 = (const float*)(ws + WS_W) + h * 64; S.b1 = (const float*)(ws + WS_A) + h * 64; S.b2 = (const float*)(ws + WS_B) + h * 64; S.b3 = (const float*)(ws + WS_K) + h * 64;
    S.b4 = (const float*)(ws + WS_R) + h * 64; S.b5 = (const float*)(ws + (L == 0 ? WS_V0 : WS_V1)) + h * 64; S.ld0 = S.ld1 = S.ld2 = S.ld3 = S.ld4 = S.ld5 = 1024; return S;
}
__device__ __forceinline__ ScanSrc gla_src(unsigned char* ws, int hd, int half) {
    const float* zG = (const float*)(ws + WS_ZG);
    ScanSrc S; S.b0 = (const float*)(ws + WS_ALPHA) + hd * 64; S.ld0 = 512; S.b1 = S.b0; S.b2 = S.b0; S.ld1 = S.ld2 = 512;
    S.b3 = zG + 512 + hd * 64; S.ld3 = NG; S.b4 = zG + hd * 64; S.ld4 = NG; S.b5 = zG + 1024 + hd * 128 + half * 64; S.ld5 = NG; return S;
}
__device__ __forceinline__ void state_store(const int wv_, float* dst  , const f2 (&s)[8][4]) {
    const int lane = TIDX & 63, j = lane & 7, g = lane >> 3;
#pragma unroll
    for (int i = 0; i < 8; ++i) { float* d = dst + (size_t)(g * 8 + i) * 64 + j * 8;
        *(f4*)(d) = (f4){s[i][0][0], s[i][0][1], s[i][1][0], s[i][1][1]}; *(f4*)(d + 4) = (f4){s[i][2][0], s[i][2][1], s[i][3][0], s[i][3][1]}; }
}
__device__ __forceinline__ void state_load(const int wv_, const float* src, f2 (&s)[8][4]) {
    const int lane = TIDX & 63, j = lane & 7, g = lane >> 3;
#pragma unroll
    for (int i = 0; i < 8; ++i) { const float* d = src + (size_t)(g * 8 + i) * 64 + j * 8; const f4 x = *(const f4*)(d), y = *(const f4*)(d + 4);
        s[i][0] = (f2){x[0], x[1]}; s[i][1] = (f2){x[2], x[3]}; s[i][2] = (f2){y[0], y[1]}; s[i][3] = (f2){y[2], y[3]}; }
}
__device__ __forceinline__ void phase_scan1(const int wv_, const Params& p, int L, float* ldsf) {
    unsigned char* ws = launder_p(p.ws);
    const int wave = __builtin_amdgcn_readfirstlane(TIDX >> 6), lane = TIDX & 63, j = lane & 7, g = lane >> 3;
    float* ldsw = ldsf + wave * 1536;
    for (int tb = blockIdx.x; tb < 378; tb += gridDim.x) {
        f2 s[8][4]; f2 pd[4];
#pragma unroll
        for (int q = 0; q < 4; ++q) pd[q] = (f2){1.f, 1.f};
        if (tb < 252) {
            const bool isM = tb >= 126; const int idx = (isM ? tb - 126 : tb) * 8 + wave; const int h = idx / 63, c = idx % 63;
#pragma unroll
            for (int i = 0; i < 8; ++i)
#pragma unroll
                for (int q = 0; q < 4; ++q) { const int e = j * 8 + q * 2, r = g * 8 + i; s[i][q] = (f2){(isM && e == r) ? 1.f : 0.f, (isM && e + 1 == r) ? 1.f : 0.f}; }
            const ScanSrc S = rwkv_src(ws, L, h);
            scan_run<true, false>(wv_, ldsw, S, c * 128, 128, s, pd, isM ? 0.f : 1.f, nullptr, 0, 0.f);
            state_store(wv_, (float*)(ws + (isM ? WS_MB : WS_NB)) + (size_t)(h * 64 + c) * 4096, s);
        } else {
            const int idx = (tb - 252) * 8 + wave; const int hh = idx / 63, c = idx % 63, hd = hh >> 1, half = hh & 1;
#pragma unroll
            for (int i = 0; i < 8; ++i)
#pragma unroll
                for (int q = 0; q < 4; ++q) s[i][q] = (f2){0.f, 0.f};
            const ScanSrc S = gla_src(ws, hd, half);
            scan_run<false, false>(wv_, ldsw, S, c * 128, 128, s, pd, 1.f, nullptr, 0, 0.f);
            state_store(wv_, (float*)(ws + WS_NGB) + ((size_t)(hd * 64 + c) * 128 + half * 64) * 64, s);
            if (half == 0 && g == 0) { float* d = (float*)(ws + WS_PGB) + (size_t)(hd * 64 + c) * 64 + j * 8;
                *(f4*)(d) = (f4){pd[0][0], pd[0][1], pd[1][0], pd[1][1]}; *(f4*)(d + 4) = (f4){pd[2][0], pd[2][1], pd[3][0], pd[3][1]}; }
        }
    }
}
__device__ __forceinline__ void phase_scan2(const int wv_, const Params& p, float* ldsM) {
    unsigned char* ws = launder_p(p.ws); const int tid = TIDX, lane = tid & 63, wave = tid >> 6;
    const float* MB = (const float*)(ws + WS_MB); const float* NB = (const float*)(ws + WS_NB); float* SB = (float*)(ws + WS_SB);
    const float* NGB = (const float*)(ws + WS_NGB); const float* PGB = (const float*)(ws + WS_PGB); float* SGB = (float*)(ws + WS_SGB);
    for (int q = blockIdx.x; q < 256; q += gridDim.x) {
        if (q < 128) {
            const int h = q >> 3, r = (q & 7) * 8 + wave;
            f4 mr0a, mr0b, mr1a, mr1b, mr2a, mr2b, mr3a, mr3b; float nr0 = 0.f, nr1 = 0.f, nr2 = 0.f, nr3 = 0.f; float s = 0.f;
            mr0a = mr0b = mr1a = mr1b = mr2a = mr2b = mr3a = mr3b = (f4){0.f, 0.f, 0.f, 0.f};
#define P2_LOAD(ma, mb, nr, cc) do { const int c_ = (cc); if (c_ < 63) { const float* Mp = MB + (size_t)(h * 64 + c_) * 4096; ma = *(const f4*)(Mp + tid * 4); mb = *(const f4*)(Mp + 2048 + tid * 4); \
                nr = NB[((size_t)(h * 64 + c_) * 64 + r) * 64 + lane]; } } while (0)
#define P2_STEP(ma, mb, nr, cc) do { __syncthreads(); *(f4*)(ldsM + tid * 4) = ma; *(f4*)(ldsM + 2048 + tid * 4) = mb; __syncthreads(); const float nv_ = nr; P2_LOAD(ma, mb, nr, (cc) + 4); \
                if ((cc) < 63) { float acc_ = nv_; _Pragma("unroll") for (int k = 0; k < 64; ++k) acc_ = fmaf(__builtin_bit_cast(float, __builtin_amdgcn_readlane(__builtin_bit_cast(int, s), k)), ldsM[k * 64 + lane], acc_); \
                    s = acc_; SB[((size_t)(h * 64 + (cc) + 1) * 64 + r) * 64 + lane] = s; } } while (0)
            P2_LOAD(mr0a, mr0b, nr0, 0); P2_LOAD(mr1a, mr1b, nr1, 1); P2_LOAD(mr2a, mr2b, nr2, 2); P2_LOAD(mr3a, mr3b, nr3, 3);
#pragma unroll 1
            for (int c = 0; c < 64; c += 4) { P2_STEP(mr0a, mr0b, nr0, c); P2_STEP(mr1a, mr1b, nr1, c + 1); P2_STEP(mr2a, mr2b, nr2, c + 2); P2_STEP(mr3a, mr3b, nr3, c + 3); }
#undef P2_LOAD
#undef P2_STEP
        } else {
            const int idx = (q - 128) * 512 + tid; const int hd = idx >> 13, row = (idx >> 6) & 127, e = idx & 63;
            float s = 0.f;
#pragma unroll 9
            for (int c = 0; c < 63; ++c) { s = PGB[(size_t)(hd * 64 + c) * 64 + e] * s + NGB[((size_t)(hd * 64 + c) * 128 + row) * 64 + e]; SGB[((size_t)(hd * 64 + c + 1) * 128 + row) * 64 + e] = s; }
        }
    }
}
__device__ __forceinline__ void phase_scan3(const int wv_, const Params& p, int L, float* ldsf) {
    unsigned char* ws = launder_p(p.ws);
    const int wave = __builtin_amdgcn_readfirstlane(TIDX >> 6);
    float* ldsw = ldsf + wave * 1536;
    for (int tb = blockIdx.x; tb < 256; tb += gridDim.x) {
        f2 s[8][4]; f2 pd[4];
#pragma unroll
        for (int q = 0; q < 4; ++q) pd[q] = (f2){1.f, 1.f};
#pragma unroll
        for (int i = 0; i < 8; ++i)
#pragma unroll
            for (int q = 0; q < 4; ++q) s[i][q] = (f2){0.f, 0.f};
        if (wave < 4) {
            const int idx = tb * 4 + wave; const int h = idx >> 6, c = idx & 63;
            if (c > 0) state_load(wv_, (const float*)(ws + WS_SB) + (size_t)(h * 64 + c) * 4096, s);
            const ScanSrc S = rwkv_src(ws, L, h);
            scan_run<true, true>(wv_, ldsw, S, c * 128, 128, s, pd, 1.f, (float*)(ws + WS_YR) + h * 64, 1024, 1.0f);
        } else {
            const int idx = tb * 4 + wave - 4; const int hh = idx >> 6, c = idx & 63, hd = hh >> 1, half = hh & 1;
            if (c > 0) state_load(wv_, (const float*)(ws + WS_SGB) + ((size_t)(hd * 64 + c) * 128 + half * 64) * 64, s);
            const ScanSrc S = gla_src(ws, hd, half);
            scan_run<false, true>(wv_, ldsw, S, c * 128, 128, s, pd, 1.f, (float*)(ws + WS_OG) + hd * 128 + half * 64, 1024, 0.125f);
        }
    }
}
__device__ __forceinline__ void phase_post(const int wv_, const Params& p, int L) {
    unsigned char* ws = launder_p(p.ws); const int lane = TIDX & 63, w = TIDX >> 6;
    const float* OG = (const float*)(ws + WS_OG); const float* YR = (const float*)(ws + WS_YR); const float* zG = (const float*)(ws + WS_ZG);
    const float* R = (const float*)(ws + WS_R); const float* K = (const float*)(ws + WS_K); const float* V = (const float*)(ws + (L == 0 ? WS_V0 : WS_V1)); const float* G = (const float*)(ws + WS_GATE);
    u16* mixA = (u16*)(ws + WS_HA);
    const int c = w * 128 + lane * 2;
    const f2 nw = *(const f2*)(p.in[11] + L * 1024 + c), rk = *(const f2*)(p.in[20] + L * 1024 + c), gw = *(const f2*)(p.in[21] + L * 1024 + c), gb = *(const f2*)(p.in[22] + L * 1024 + c);
    for (int t = blockIdx.x; t < T; t += gridDim.x) {
        { const f2 o = *(const f2*)(OG + (size_t)t * 1024 + c); const float ss = wave_sum(o[0] * o[0] + o[1] * o[1]); const float rs = rsqrtf(ss * (1.0f / 128.0f) + 1e-6f);
          const f2 gg = *(const f2*)(zG + (size_t)t * NG + 2048 + c);
          const float r0 = ((o[0] * rs) * nw[0]) * (gg[0] * sigm(gg[0])), r1 = ((o[1] * rs) * nw[1]) * (gg[1] * sigm(gg[1]));
          *(unsigned*)(mixA + (size_t)t * 2048 + c) = pk_bf16(r0, r1); }
        { const size_t o = (size_t)t * 1024 + c; const f2 y = *(const f2*)(YR + o); const float mean = half_sum(y[0] + y[1]) * (1.0f / 64.0f); const float d0 = y[0] - mean, d1 = y[1] - mean;
          const float var = half_sum(d0 * d0 + d1 * d1) * (1.0f / 64.0f); const float rs = rsqrtf(var + 64e-5f);
          const f2 r = *(const f2*)(R + o), k = *(const f2*)(K + o), v = *(const f2*)(V + o), gt = *(const f2*)(G + o);
          const float bs = half_sum(r[0] * k[0] * rk[0] + r[1] * k[1] * rk[1]);
          const float o0 = ((d0 * rs) * gw[0] + gb[0] + bs * v[0]) * gt[0], o1 = ((d1 * rs) * gw[1] + gb[1] + bs * v[1]) * gt[1];
          *(unsigned*)(mixA + (size_t)t * 2048 + 1024 + c) = pk_bf16(o0, o1); }
    }
}
template <class Epi> __device__ __forceinline__ void run_gemm(const int wv_, unsigned char* lds, const u16* A, const u16* Bt, int M, int N, int K, const Epi& E) {
    pg8::Gemm g{A, Bt, M, N, K}; pg8::StaticOrder S; S.init(M, N, (int)gridDim.x, (int)blockIdx.x);
    pg8::gemm_phase<Epi, pg8::StaticOrder, false>(wv_, (PG8_LAS unsigned char*)lds, g, S, E, nullptr);
}
#define WSP() unsigned char* ws = launder_p(p.ws); const float* mod = (const float*)(ws + WS_MOD); u16* hA = (u16*)(ws + WS_HA); float* Y = (float*)(ws + WS_Y); (void)mod; (void)hA; (void)Y
__global__ void __launch_bounds__(512) mega(Params p) {
    extern __shared__ __attribute__((aligned(16))) unsigned char lds[];
    cg::grid_group grid = cg::this_grid();
    float* ldsf = (float*)lds; unsigned bar_target = 0u;
    const int wv_ = __builtin_amdgcn_readfirstlane((int)threadIdx.x >> 6);
    phase_ada(wv_, p, ldsf); phase_conv(wv_, p, 0, ldsf);
    grid.sync();
    { WSP(); phase_rowwise(wv_, p.in[0], nullptr, nullptr, nullptr, nullptr, p.in[4], mod + 2048, mod, hA); }
    grid_bar(wv_, p.ws, bar_target);
#pragma unroll 1
    for (int L0 = 0; L0 < 2; ++L0) {
        { WSP(); EpiZ E{(float*)(ws + WS_ZG), (float*)(ws + WS_ZR)}; run_gemm(wv_, lds, hA, (const u16*)(ws + WS_WIN), T, NINP, 2048, E); }
        grid_bar(wv_, p.ws, bar_target);
        phase_prep(wv_, p, launder_s(L0));
        grid_bar(wv_, p.ws, bar_target);
        { WSP(); const int L = launder_s(L0); EpiW E{(float*)(ws + WS_W), p.in[13] + L * 1024}; run_gemm(wv_, lds, (const u16*)(ws + WS_ACAT1), (const u16*)(ws + WS_LRT), T, 1024, 256, E); }
        { WSP(); const int L = launder_s(L0); EpiA E{(float*)(ws + WS_B), (float*)(ws + WS_K), p.in[15] + L * 1024, p.in[19] + L * 1024}; run_gemm(wv_, lds, (const u16*)(ws + WS_ACAT1), (const u16*)(ws + WS_LRT) + 1024 * 256, T, 1024, 256, E); }
        if (launder_s(L0) == 1) { WSP(); EpiV E{(float*)(ws + WS_V1), (const float*)(ws + WS_V0), p.in[26]}; run_gemm(wv_, lds, (const u16*)(ws + WS_ACAT1), (const u16*)(ws + WS_LRT) + 2048 * 256, T, 1024, 256, E); }
        { WSP(); EpiPlain E{(float*)(ws + WS_GATE), 1024}; run_gemm(wv_, lds, (const u16*)(ws + WS_ACAT2), (const u16*)(ws + WS_GUPT), T, 1024, 256, E); }
        grid_bar(wv_, p.ws, bar_target);
        phase_scan1(wv_, p, launder_s(L0), ldsf);
        grid_bar(wv_, p.ws, bar_target);
        phase_scan2(wv_, p, ldsf);
        grid_bar(wv_, p.ws, bar_target);
        phase_scan3(wv_, p, launder_s(L0), ldsf);
        grid_bar(wv_, p.ws, bar_target);
        phase_post(wv_, p, launder_s(L0));
        grid_bar(wv_, p.ws, bar_target);
        { WSP(); EpiPlain E{Y, 2048}; run_gemm(wv_, lds, hA, (const u16*)(ws + WS_WOUT), T, 2048, 2048, E); }
        grid_bar(wv_, p.ws, bar_target);
        { WSP(); const int L = launder_s(L0); const float* modL = mod + L * 12288;
          phase_rowwise(wv_, L == 0 ? p.in[0] : p.out, Y, modL + 4096, p.in[5] + L * 2048, p.out, p.in[6] + L * 2048, modL + 8192, modL + 6144, hA); }
        grid_bar(wv_, p.ws, bar_target);
        { WSP(); EpiRelu2 E{(u16*)(ws + WS_U), 8192}; run_gemm(wv_, lds, hA, (const u16*)(ws + WS_WFF1), T, 8192, 2048, E); }
        grid_bar(wv_, p.ws, bar_target);
        { WSP(); EpiPlain E{Y, 2048}; run_gemm(wv_, lds, (const u16*)(ws + WS_U), (const u16*)(ws + WS_WFF2), T, 2048, 8192, E); }
        grid_bar(wv_, p.ws, bar_target);
        if (L0 == 0) {
            { WSP(); phase_rowwise(wv_, p.out, Y, mod + 10240, p.in[7], p.out, p.in[4] + 2048, mod + 12288 + 2048, mod + 12288, hA); }
            phase_conv(wv_, p, 1, ldsf);
            grid_bar(wv_, p.ws, bar_target);
        } else {
            { WSP(); phase_rowwise(wv_, p.out, Y, mod + 12288 + 10240, p.in[7] + 2048, p.out, nullptr, nullptr, nullptr, nullptr); }
        }
    }
}
extern "C" void kernel_launch(void* const* d_in, const int* in_sizes, int n_in, void* d_out, int out_size, void* d_ws, size_t ws_size, hipStream_t stream) {
    static int grid_blocks = 0;
    constexpr size_t kLds = 131072;
    if (!grid_blocks) {
        int dev = 0, cus = 0, per_cu = 0;
        (void)hipGetDevice(&dev);
        (void)hipDeviceGetAttribute(&cus, hipDeviceAttributeMultiprocessorCount, dev);
        (void)hipFuncSetAttribute((const void*)mega, hipFuncAttributeMaxDynamicSharedMemorySize, (int)kLds);
        (void)hipOccupancyMaxActiveBlocksPerMultiprocessor(&per_cu, (const void*)mega, 512, kLds);
        if (ws_size < WS_END || n_in != 30) { fprintf(stderr, "kernel_launch: workspace %zu < %zu or n_in %d != 30\n", ws_size, (size_t)WS_END, n_in); grid_blocks = -1; return; }
        if (per_cu < 1) fprintf(stderr, "kernel_launch: occupancy query says %d blocks/CU\n", per_cu);
        grid_blocks = cus;
    }
    if (grid_blocks < 0) return;
    (void)hipMemsetAsync((unsigned char*)d_ws + WS_CTL, 0, 256, stream);
    Params p{};
    for (int i = 0; i < 30; ++i) p.in[i] = (const float*)d_in[i];
    p.out = (float*)d_out; p.ws = (unsigned char*)d_ws;
    void* args[] = {&p};
    hipError_t e = hipLaunchCooperativeKernel((void*)mega, dim3(grid_blocks), dim3(512), args, kLds, stream);
    if (e != hipSuccess) fprintf(stderr, "cooperative launch failed: %s (grid %d)\n", hipGetErrorString(e), grid_blocks);
}
```

```cpp
#define DUP_MASK 0
#include <hip/hip_runtime.h>
#include <hip/hip_cooperative_groups.h>
#include <cstdio>
namespace cg = cooperative_groups;
__device__ __forceinline__ int launder_v(int x) { asm volatile("" : "+v"(x)); return x; }
__device__ __forceinline__ int launder_s(int x) { asm volatile("" : "+s"(x)); return x; }
__device__ __forceinline__ int lane_id_v() { int x; asm volatile("v_mbcnt_lo_u32_b32 %0, -1, 0\n\tv_mbcnt_hi_u32_b32 %0, -1, %0" : "=v"(x)); return x; }
#define TIDX (launder_s(wv_) * 64 + lane_id_v())
__device__ __forceinline__ unsigned char* launder_p(unsigned char* x) { unsigned long long v = (unsigned long long)x; asm volatile("" : "+s"(v)); return (unsigned char*)(__attribute__((address_space(1))) unsigned char*)v; }
namespace pg8 {
#define PG8_LAS __attribute__((address_space(3)))
typedef unsigned short bf16_t;
typedef short bf16x8 __attribute__((ext_vector_type(8)));
typedef float f32x4 __attribute__((ext_vector_type(4)));
typedef unsigned u32x4 __attribute__((ext_vector_type(4)));
constexpr int BM = 256, BK = 64, HALF = 128, HTB = HALF * BK * 2  , STAGE_BYTES = 8 * HTB, NXCD = 8, WGM = 8;

__host__ __device__ __forceinline__ int lds_byte(int r, int c) { const int st = (r >> 4) * 2 + (c >> 5), rr = r & 15, cc = c & 31, ob = rr * 64 + cc * 2; return st * 1024 + (ob ^ (((ob >> 9) & 1) << 5)); }
__host__ __device__ __forceinline__ void stage_rc(int b, int& R, int& C) { const int st = b / 1024, sb = b % 1024, swz = sb ^ (((sb >> 9) & 1) << 5); R = (st >> 1) * 16 + swz / 64; C = (st & 1) * 32 + (swz % 64) / 2; }
__host__ __device__ __forceinline__ int perm32(int rho) { const int n = rho >> 4, i = rho & 15; return 8 * (i >> 2) + 4 * n + (i & 3); }

struct Unit { int pm, pn; };
struct Gemm { const bf16_t* A; const bf16_t* Bt; int M, N, K; const bf16_t* A2; int a2_lo, a2_hi; };

struct StaticOrder {
    int nM, nN, nwg, G, c;
    __host__ __device__ void init(int M, int N, int G_, int c_) { nM = M / BM; nN = N / BM; nwg = nM * nN; G = G_; c = c_; }
    __host__ __device__ bool next(int i, Unit& u) const {
        const long L = (long)i * G + c; if (L >= nwg) return false;
        int wgid = (int)L; { const int q = nwg / NXCD, r = nwg % NXCD, xcd = wgid % NXCD, off = wgid / NXCD; wgid = (xcd < r ? xcd * (q + 1) : r * (q + 1) + (xcd - r) * q) + off; }
        const int nig = WGM * nN, gid = wgid / nig, fm = gid * WGM, gsz = (nM - fm) < WGM ? (nM - fm) : WGM;
        u.pm = fm + ((wgid % nig) % gsz); u.pn = (wgid % nig) / gsz; return true;
    }
    __device__ __forceinline__ void a_ready(const Unit&) const {}
    __device__ __forceinline__ void done(const Unit&) const {}
};
__device__ __forceinline__ unsigned cvt_pk_bf16(float lo, float hi) { unsigned r; asm volatile("v_cvt_pk_bf16_f32 %0, %1, %2" : "=v"(r) : "v"(lo), "v"(hi)); return r; }
template <class Epi, class Sched, bool STAMP = false>
__device__ __forceinline__ void gemm_phase(const int wv_, PG8_LAS unsigned char* lds, const Gemm g, const Sched& S, const Epi& E, unsigned long long* stamps) {
    const int tid = TIDX, wid = __builtin_amdgcn_readfirstlane(tid >> 6), lane = tid & 63, wr = wid >> 2, wc = wid & 3, fr = lane & 15, fq = lane >> 4;
    const int K = g.K, nt = K / BK;
    int ts_lo = 0, ts_hi = 0, nts = 0; const unsigned long long rt_entry = STAMP ? (unsigned long long)wall_clock64() : 0ull;
#define PG8_STAMP() do { if (STAMP && wid == 0 && nts < 64) { const unsigned long long _c = (unsigned long long)clock64(); \
        ts_lo = (lane == nts) ? (int)(unsigned)_c : ts_lo; ts_hi = (lane == nts) ? (int)(unsigned)(_c >> 32) : ts_hi; ++nts; } } while (0)
    PG8_STAMP();
    unsigned voffA[2], voffB[2];
#pragma unroll
    for (int i = 0; i < 2; ++i) { int R, C; stage_rc(tid * 16 + i * 8192, R, C); const int Rb = Epi::PERM ? ((R & ~31) + perm32(R & 31)) : R;
        voffA[i] = (unsigned)(R * K + C) * 2u; voffB[i] = (unsigned)(Rb * K + C) * 2u; }
    const size_t kstep = (size_t)(BK * 2);
    const size_t hstep = (size_t)HALF * K * 2;
    const size_t tstep = 2 * hstep;
    const unsigned ldsw = (unsigned)wid * 1024u;
    const int aoff = lds_byte(wr * 64 + fr, fq * 8), boff = lds_byte(wc * 32 + fr, fq * 8);
#define PG8_SA(b, h) (((b) * 2 + (h)) * HTB)
#define PG8_SB(b, h) ((4 + (b) * 2 + (h)) * HTB)
#define PG8_STAGE(bufoff, gbase, voff) do { _Pragma("unroll") for (int _i = 0; _i < 2; ++_i) \
        __builtin_amdgcn_global_load_lds((const unsigned*)((const char*)(gbase) + (voff)[_i]), (PG8_LAS unsigned*)(lds + (bufoff) + ldsw + _i * 8192), 16, 0, 0); } while (0)
#define PG8_LDA(dst, b, h) do { _Pragma("unroll") for (int m = 0; m < 4; ++m) _Pragma("unroll") for (int k = 0; k < 2; ++k) dst[m][k] = *(const PG8_LAS bf16x8*)(lds + PG8_SA(b, h) + aoff + m * 2048 + k * 1024); } while (0)
#define PG8_LDB(dst, b, h) do { _Pragma("unroll") for (int n = 0; n < 2; ++n) _Pragma("unroll") for (int k = 0; k < 2; ++k) dst[n][k] = *(const PG8_LAS bf16x8*)(lds + PG8_SB(b, h) + boff + n * 2048 + k * 1024); } while (0)
#define PG8_MMA(ai, bj, At, Bt) do { __builtin_amdgcn_s_setprio(1); _Pragma("unroll") for (int m = 0; m < 4; ++m) _Pragma("unroll") for (int n = 0; n < 2; ++n) _Pragma("unroll") for (int k = 0; k < 2; ++k) \
        acc[ai][bj][m][n] = __builtin_amdgcn_mfma_f32_16x16x32_bf16(Bt[n][k], At[m][k], acc[ai][bj][m][n], 0, 0, 0); __builtin_amdgcn_s_setprio(0); } while (0)
#define PG8_WAIT_V(n) asm volatile("s_waitcnt vmcnt(" #n ")" ::: "memory")
#define PG8_WAIT_L(n) asm volatile("s_waitcnt lgkmcnt(" #n ")" ::: "memory")
#define PG8_BAR __builtin_amdgcn_s_barrier()
#define PG8_SCHED __builtin_amdgcn_sched_barrier(0)
    Unit cur, nxt; int ui = 0;
    if (!S.next(0, cur)) return;
    f32x4 acc[2][2][4][2];
#pragma unroll
    for (int a = 0; a < 2; ++a)
#pragma unroll
        for (int b = 0; b < 2; ++b)
#pragma unroll
            for (int m = 0; m < 4; ++m)
#pragma unroll
                for (int n = 0; n < 2; ++n) acc[a][b][m][n] = (f32x4){0.f, 0.f, 0.f, 0.f};
    bf16x8 At[4][2], B0[2][2], B1[2][2];
    const char* cA = (const char*)((cur.pn >= g.a2_lo && cur.pn < g.a2_hi) ? g.A2 : g.A) + (size_t)cur.pm * tstep; const char* cB = (const char*)g.Bt + (size_t)cur.pn * tstep;
    S.a_ready(cur);
    PG8_STAGE(PG8_SB(0, 0), cB, voffB); PG8_STAGE(PG8_SA(0, 0), cA, voffA); PG8_STAGE(PG8_SB(0, 1), cB + hstep, voffB); PG8_STAGE(PG8_SA(0, 1), cA + hstep, voffA);
    if (wr == 1) PG8_BAR;
    PG8_WAIT_V(4); PG8_BAR;
    PG8_STAGE(PG8_SB(1, 0), cB + kstep, voffB); PG8_STAGE(PG8_SA(1, 0), cA + kstep, voffA); PG8_STAGE(PG8_SB(1, 1), cB + hstep + kstep, voffB);
    PG8_WAIT_V(6); PG8_BAR;
    PG8_STAMP();
    for (;;) {
        const bool has_next = S.next(ui + 1, nxt);
        const char* nA = has_next ? (const char*)((nxt.pn >= g.a2_lo && nxt.pn < g.a2_hi) ? g.A2 : g.A) + (size_t)nxt.pm * tstep : cA; const char* nB = has_next ? (const char*)g.Bt + (size_t)nxt.pn * tstep : cB;
        for (int t = 0; t < nt; t += 2) {
            const bool last = (t == nt - 2);
            const char* a1 = cA + (size_t)(t + 1) * kstep;
            const char* a2 = last ? nA : cA + (size_t)(t + 2) * kstep; const char* b2 = last ? nB : cB + (size_t)(t + 2) * kstep;
            const char* a3 = a2 + kstep; const char* b3 = b2 + kstep;
            if (last && has_next) S.a_ready(nxt);
            PG8_LDB(B0, 0, 0); PG8_SCHED; PG8_LDA(At, 0, 0); PG8_STAGE(PG8_SA(1, 1), a1 + hstep, voffA);
            PG8_WAIT_L(8); PG8_BAR; PG8_WAIT_L(0); PG8_MMA(0, 0, At, B0); PG8_BAR; PG8_SCHED;
            PG8_LDB(B1, 0, 1); PG8_STAGE(PG8_SB(0, 0), b2, voffB);
            PG8_BAR; PG8_WAIT_L(0); PG8_MMA(0, 1, At, B1); PG8_BAR;
            PG8_LDA(At, 0, 1); PG8_STAGE(PG8_SA(0, 0), a2, voffA);
            PG8_BAR; PG8_WAIT_L(0); PG8_MMA(1, 0, At, B0); PG8_BAR; PG8_SCHED;
            PG8_STAGE(PG8_SB(0, 1), b2 + hstep, voffB);
            PG8_WAIT_V(6); PG8_BAR; PG8_MMA(1, 1, At, B1); PG8_BAR;
            PG8_LDB(B0, 1, 0); PG8_SCHED; PG8_LDA(At, 1, 0); PG8_STAGE(PG8_SA(0, 1), a2 + hstep, voffA);
            PG8_WAIT_L(8); PG8_BAR; PG8_WAIT_L(0); PG8_MMA(0, 0, At, B0); PG8_BAR; PG8_SCHED;
            PG8_LDB(B1, 1, 1); PG8_STAGE(PG8_SB(1, 0), b3, voffB);
            PG8_BAR; PG8_WAIT_L(0); PG8_MMA(0, 1, At, B1); PG8_BAR;
            PG8_LDA(At, 1, 1); PG8_STAGE(PG8_SA(1, 0), a3, voffA);
            PG8_BAR; PG8_WAIT_L(0); PG8_MMA(1, 0, At, B0); PG8_BAR; PG8_SCHED;
            PG8_STAGE(PG8_SB(1, 1), b3 + hstep, voffB);
            PG8_WAIT_V(6); PG8_BAR; PG8_MMA(1, 1, At, B1); PG8_BAR;
        }
        PG8_STAMP();
        if constexpr (!Epi::AFTER_DRAIN) { E(acc, cur, wr, wc, fr, fq); S.done(cur); }
        PG8_STAMP();
        if (!has_next) break;
#pragma unroll
        for (int a = 0; a < 2; ++a)
#pragma unroll
            for (int b = 0; b < 2; ++b)
#pragma unroll
                for (int m = 0; m < 4; ++m)
#pragma unroll
                    for (int n = 0; n < 2; ++n) acc[a][b][m][n] = (f32x4){0.f, 0.f, 0.f, 0.f};
        cur = nxt; cA = nA; cB = nB; ++ui;
    }
    PG8_WAIT_V(0);
    if (wr == 0) PG8_BAR;
    PG8_BAR;
    if constexpr (Epi::AFTER_DRAIN) { E.fused(acc, cur, wr, wc, fr, fq, lds, wid, lane); S.done(cur); }
    PG8_STAMP();
    if (STAMP && wid == 0) { stamps[lane] = lane < nts ? (((unsigned long long)(unsigned)ts_hi << 32) | (unsigned)ts_lo) : 0ull;
        if (lane == 62) stamps[62] = rt_entry; if (lane == 63) stamps[63] = (unsigned long long)wall_clock64(); }
#undef PG8_STAMP
#undef PG8_SA
#undef PG8_SB
#undef PG8_STAGE
#undef PG8_LDA
#undef PG8_LDB
#undef PG8_MMA
#undef PG8_WAIT_V
#undef PG8_WAIT_L
#undef PG8_BAR
#undef PG8_SCHED
}
}
typedef unsigned short u16;
typedef float f4 __attribute__((ext_vector_type(4)));
typedef float f2 __attribute__((ext_vector_type(2)));
typedef unsigned u32x2 __attribute__((ext_vector_type(2)));
typedef unsigned u32x4 __attribute__((ext_vector_type(4)));
using pg8::f32x4;
constexpr int T = 8192, D = 2048, DFF = 8192;
constexpr int NG = 3328, NR = 3584, NINP = 6912;
constexpr size_t MiB = 1048576;
constexpr size_t WS_WIN = 0, WS_WOUT = 27 * MiB, WS_WFF1 = 35 * MiB, WS_WFF2 = 67 * MiB, WS_LRT = 99 * MiB, WS_GUPT = 101 * MiB, WS_MOD = 102 * MiB,
                 WS_ACAT1 = 103 * MiB, WS_ACAT2 = 107 * MiB, WS_HA = 112 * MiB, WS_Y = 144 * MiB, WS_YR = 144 * MiB, WS_OG = 176 * MiB,
                 WS_ZG = 208 * MiB, WS_ZR = 312 * MiB, WS_NB = 312 * MiB, WS_MB = 328 * MiB, WS_SB = 344 * MiB, WS_NGB = 360 * MiB, WS_SGB = 376 * MiB, WS_PGB = 392 * MiB,
                 WS_U = 208 * MiB, WS_V0 = 424 * MiB, WS_W = 456 * MiB, WS_A = 488 * MiB, WS_B = 520 * MiB, WS_K = 552 * MiB, WS_R = 584 * MiB, WS_V1 = 616 * MiB,
                 WS_GATE = 648 * MiB, WS_ALPHA = 680 * MiB, WS_CTL = 696 * MiB, WS_BD = 393 * MiB  , WS_GG = 394 * MiB  , WS_END = 697 * MiB;

struct Params { const float* in[30]; float* out; unsigned char* ws; };

__device__ __forceinline__ unsigned pk_bf16(float lo, float hi) { return pg8::cvt_pk_bf16(lo, hi); }
__device__ __forceinline__ u16 to_bf16(float v) { return (u16)(pk_bf16(v, 0.f) & 0xffffu); }
__device__ __forceinline__ float sigm(float x) { return 1.0f / (1.0f + __expf(-x)); }
template <int CTRL> __device__ __forceinline__ float dppf(float x) { return __builtin_bit_cast(float, __builtin_amdgcn_mov_dpp(__builtin_bit_cast(int, x), CTRL, 0xf, 0xf, true)); }
__device__ __forceinline__ float red8(float x) { x += dppf<0xB1>(x); x += dppf<0x4E>(x); x += dppf<0x141>(x); return x; }

__device__ __forceinline__ float red16(float x) { x = red8(x); x += dppf<0x140>(x); return x; }
__device__ __forceinline__ float rl(float x, int l) { return __builtin_bit_cast(float, __builtin_amdgcn_readlane(__builtin_bit_cast(int, x), l)); }
__device__ __forceinline__ float wave_sum(float v) { const float r = red16(v); return (rl(r, 0) + rl(r, 16)) + (rl(r, 32) + rl(r, 48)); }
__device__ __forceinline__ float half_sum(float v) { const float r = red16(v); const float lo = rl(r, 0) + rl(r, 16), hi = rl(r, 32) + rl(r, 48); return (lane_id_v() & 32) ? hi : lo; }
#define XB_TMO      128
#define XB_XCNT(j)  (256  + 64 * (j))
#define XB_XSUB(j)  (1280 + 64 * (j))
#define XB_XGEN(j)  (2304 + 64 * (j))
#define XB_TOP      3328
#define XB_TOPGEN   3392
#define XCD_BAR_WORDS 3456
#define XB_SPIN_CAP (1u << 22)
#define LAS __attribute__((address_space(3)))
__device__ __forceinline__ unsigned xb_ld(unsigned* p)              { return __hip_atomic_load(p, __ATOMIC_RELAXED, __HIP_MEMORY_SCOPE_AGENT); }
__device__ __forceinline__ unsigned xb_add(unsigned* p, unsigned v) { return __hip_atomic_fetch_add(p, v, __ATOMIC_RELAXED, __HIP_MEMORY_SCOPE_AGENT); }
__device__ __forceinline__ unsigned xb_xcc_id() { return (unsigned)__builtin_amdgcn_s_getreg((3 << 11) | 20) & 0xFu; }
#define XB_SPIN(cond, bar) do { unsigned _sp = 0; while (cond) { __builtin_amdgcn_s_sleep(1); \
    if ((++_sp & 255u) == 0u) { if (xb_ld(&(bar)[XB_TMO])) break; if (_sp > XB_SPIN_CAP) { atomicAdd(&(bar)[XB_TMO], 1u); break; } } } } while (0)
struct XcdBarrier { unsigned* bar; unsigned x; volatile LAS unsigned* st; };
__device__ __forceinline__ XcdBarrier xcd_barrier_post(const int wv_, unsigned* bar, volatile LAS unsigned* st) {
    XcdBarrier b; b.bar = bar; b.x = xb_xcc_id(); b.st = st;
    if (TIDX == 0) (void)xb_add(&bar[XB_XCNT(b.x)], 1u);
    return b;
}
__device__ __forceinline__ void xcd_barrier_complete(unsigned* bar, unsigned x, unsigned& nloc, unsigned& nx) {
    const unsigned G = gridDim.x * gridDim.y * gridDim.z;
    unsigned sum, cnt, mine, sp = 0u;
    for (;;) {
        sum = 0u; cnt = 0u; mine = 0u;
#pragma unroll
        for (unsigned j = 0; j < 16; ++j) { const unsigned c = xb_ld(&bar[XB_XCNT(j)]); sum += c; cnt += (c > 0u) ? 1u : 0u; mine = (j == x) ? c : mine; }
        if (sum == G) break;
        __builtin_amdgcn_s_sleep(1);
        if ((++sp & 255u) == 0u) { if (xb_ld(&bar[XB_TMO])) break; if (sp > XB_SPIN_CAP) { atomicAdd(&bar[XB_TMO], 1u); break; } }
    }
    nloc = mine > 0u ? mine : 1u; nx = cnt > 0u ? cnt : 1u;
}
__device__ __forceinline__ void xcd_barrier(const int wv_, const XcdBarrier& b) {
    asm volatile("s_waitcnt vmcnt(0)" ::: "memory");
    __syncthreads();
    unsigned* bar = (unsigned*)launder_p((unsigned char*)b.bar); const unsigned bx = (unsigned)launder_s((int)b.x);
    if (TIDX == 0) {
        __builtin_amdgcn_s_waitcnt(0);
        unsigned nloc = b.st[0], nx = b.st[1];
        if (nloc == 0u) { xcd_barrier_complete(bar, bx, nloc, nx); b.st[0] = nloc; b.st[1] = nx; }
        const unsigned old = xb_add(&bar[XB_XSUB(bx)], 1u);
        const unsigned gen = old / nloc;
        if (old + 1u == (gen + 1u) * nloc) {
            __builtin_amdgcn_fence(__ATOMIC_RELEASE, "agent");
            asm volatile("s_waitcnt vmcnt(0)" ::: "memory");
            const unsigned og = xb_add(&bar[XB_TOP], 1u);
            const unsigned tg = og / nx;
            if (og + 1u == (tg + 1u) * nx) xb_add(&bar[XB_TOPGEN], 1u);
            else XB_SPIN(xb_ld(&bar[XB_TOPGEN]) == tg, bar);
            __builtin_amdgcn_fence(__ATOMIC_ACQUIRE, "agent");
            xb_add(&bar[XB_XGEN(bx)], 1u);
            asm volatile("s_waitcnt vmcnt(0)" ::: "memory");
        } else {
            XB_SPIN(xb_ld(&bar[XB_XGEN(bx)]) == gen, bar);
            __builtin_amdgcn_fence(__ATOMIC_ACQUIRE, "agent");
            asm volatile("s_waitcnt vmcnt(0)" ::: "memory");
        }
    }
    __syncthreads();
}
struct ConvJob { const float* src; int src_ld; u16* dst; int dst_ld; int nrows, nk; };
constexpr int NJOBS = 15;
__device__ __forceinline__ ConvJob conv_job(const Params& p, int L, int j) {
    unsigned char* ws = launder_p(p.ws);
    u16* WinT = (u16*)(ws + WS_WIN); u16* WoutT = (u16*)(ws + WS_WOUT); u16* Wff1T = (u16*)(ws + WS_WFF1); u16* Wff2T = (u16*)(ws + WS_WFF2);
    u16* LrT = (u16*)(ws + WS_LRT); u16* GupT = (u16*)(ws + WS_GUPT);
    ConvJob J; J.src = nullptr; J.src_ld = 0; J.dst = WinT; J.dst_ld = 2048; J.nrows = 0; J.nk = 0;
    if (j == 0)       { J.src = p.in[8] + (size_t)L * 2048 * 6608;        J.src_ld = 6608; J.dst = WinT;                       J.dst_ld = 2048; J.nrows = 3088; J.nk = 2048; }
    else if (j == 1)  {                                                                    J.dst = WinT + (size_t)3088 * 2048; J.dst_ld = 2048; J.nrows = 240;  J.nk = 2048; }
    else if (j == 2)  { J.src = p.in[8] + (size_t)L * 2048 * 6608 + 3088; J.src_ld = 6608; J.dst = WinT + (size_t)3328 * 2048; J.dst_ld = 2048; J.nrows = 3520; J.nk = 2048; }
    else if (j == 3)  { J.src = (L == 1) ? p.in[23] : nullptr;            J.src_ld = 64;   J.dst = WinT + (size_t)6848 * 2048; J.dst_ld = 2048; J.nrows = 64;   J.nk = 2048; }
    else if (j == 4)  { J.src = p.in[27] + (size_t)L * 2048 * 2048;       J.src_ld = 2048; J.dst = WoutT;                      J.dst_ld = 2048; J.nrows = 2048; J.nk = 2048; }
    else if (j == 5)  { J.src = p.in[28] + (size_t)L * 2048 * 8192;       J.src_ld = 8192; J.dst = Wff1T;                      J.dst_ld = 2048; J.nrows = 8192; J.nk = 2048; }
    else if (j == 6)  { J.src = p.in[29] + (size_t)L * 8192 * 2048;       J.src_ld = 2048; J.dst = Wff2T;                      J.dst_ld = 8192; J.nrows = 2048; J.nk = 8192; }
    else if (j == 7)  { J.src = p.in[14] + (size_t)L * 96 * 1024;         J.src_ld = 1024; J.dst = LrT;                        J.dst_ld = 256;  J.nrows = 1024; J.nk = 96; }
    else if (j == 8)  {                                                                    J.dst = LrT + 96;                   J.dst_ld = 256;  J.nrows = 1024; J.nk = 160; }
    else if (j == 9)  {                                                                    J.dst = LrT + 1024 * 256;           J.dst_ld = 256;  J.nrows = 1024; J.nk = 96; }
    else if (j == 10) { J.src = p.in[16] + (size_t)L * 96 * 1024;         J.src_ld = 1024; J.dst = LrT + 1024 * 256 + 96;      J.dst_ld = 256;  J.nrows = 1024; J.nk = 96; }
    else if (j == 11) {                                                                    J.dst = LrT + 1024 * 256 + 192;     J.dst_ld = 256;  J.nrows = 1024; J.nk = 64; }
    else if (j == 12) {                                                                    J.dst = LrT + 3072 * 256;           J.dst_ld = 256;  J.nrows = 1024; J.nk = 192; }
    else if (j == 13) { J.src = (L == 1) ? p.in[25] : nullptr;            J.src_ld = 1024; J.dst = LrT + 3072 * 256 + 192;     J.dst_ld = 256;  J.nrows = 1024; J.nk = 64; }
    else              { J.src = p.in[17] + (size_t)L * 256 * 1024;        J.src_ld = 1024; J.dst = LrT + 2048 * 256;           J.dst_ld = 256;  J.nrows = 1024; J.nk = 256; }
    return J;
}
struct ConvTile { ConvJob J; int n0, k0; };
__device__ __forceinline__ ConvTile conv_tile(const Params& p, int L, int g) {
    int rem = g, jj = 0; ConvTile t; t.J = conv_job(p, L, 0);
    for (;;) { const int cnt = ((t.J.nrows + 255) >> 8) * ((t.J.nk + 63) >> 6); if (rem < cnt) break; rem -= cnt; ++jj; t.J = conv_job(p, L, jj); }
    const int ntn = (t.J.nrows + 255) >> 8; t.n0 = (rem % ntn) * 256; t.k0 = (rem / ntn) * 64; return t;
}
#define CONV_LOAD(tt, vv) do { const bool okn_ = ((tt).J.src != nullptr) && ((tt).n0 + lane * 4) < (tt).J.nrows; \
        _Pragma("unroll") for (int kk = 0; kk < 8; ++kk) { const int k_ = wave * 8 + kk; vv[kk] = (f4){0.f, 0.f, 0.f, 0.f}; \
            if (okn_ && ((tt).k0 + k_) < (tt).J.nk) vv[kk] = *(const f4*)((tt).J.src + (size_t)((tt).k0 + k_) * (tt).J.src_ld + (tt).n0 + lane * 4); } } while (0)
__device__ __forceinline__ void phase_conv(const int wv_, const Params& p, int L, float* tile) {
    const int tid = TIDX, lane = tid & 63, wave = tid >> 6;
    int total = 0;
    for (int j = 0; j < NJOBS; ++j) { const ConvJob J = conv_job(p, L, j); total += ((J.nrows + 255) >> 8) * ((J.nk + 63) >> 6); }
    int g = blockIdx.x;
    if (g >= total) return;
    ConvTile cur = conv_tile(p, L, g);
    f4 v[8];
    CONV_LOAD(cur, v);
    for (; g < total; g += gridDim.x) {
#pragma unroll
        for (int kk = 0; kk < 8; ++kk) *(f4*)(tile + (wave * 8 + kk) * 260 + lane * 4) = v[kk];
        const int gn = g + gridDim.x; ConvTile nxt = cur;
        if (gn < total) { nxt = conv_tile(p, L, gn); CONV_LOAD(nxt, v); }
        __syncthreads();
        { const int nr = tid >> 1, kh = (tid & 1) * 32;
          if ((cur.n0 + nr) < cur.J.nrows) {
#pragma unroll
              for (int c4 = 0; c4 < 4; ++c4) { const int kc = kh + c4 * 8;
                  if ((cur.k0 + kc) < cur.J.nk) { u32x4 w; const float* s = tile + kc * 260 + nr;
                      w.x = pk_bf16(s[0 * 260], s[1 * 260]); w.y = pk_bf16(s[2 * 260], s[3 * 260]); w.z = pk_bf16(s[4 * 260], s[5 * 260]); w.w = pk_bf16(s[6 * 260], s[7 * 260]);
                      *(u32x4*)(cur.J.dst + (size_t)(cur.n0 + nr) * cur.J.dst_ld + cur.k0 + kc) = w; } } } }
        __syncthreads();
        cur = nxt;
    }
}
__device__ __forceinline__ void phase_ada(const int wv_, const Params& p, float* ldsf) {
    const float* c = p.in[1]; float* mod = (float*)(p.ws + WS_MOD);
    const int tid = TIDX, c4 = tid & 31, kg = tid >> 5;
    for (int task = blockIdx.x; task < 192; task += gridDim.x) {
        const int L = task / 96, cb = task % 96;
        const float* W = p.in[2] + (size_t)L * 2048 * 12288 + cb * 128 + c4 * 4;
        f4 acc = (f4){0.f, 0.f, 0.f, 0.f};
#pragma unroll 8
        for (int k = kg; k < 2048; k += 16) { const float cv = c[k]; const float s = cv / (1.0f + __expf(-cv)); const f4 w = *(const f4*)(W + (size_t)k * 12288); acc += s * w; }
        *(f4*)(ldsf + kg * 128 + c4 * 4) = acc;
        __syncthreads();
        if (tid < 128) { float s = 0.f; for (int g2 = 0; g2 < 16; ++g2) s += ldsf[g2 * 128 + tid]; mod[L * 12288 + cb * 128 + tid] = s + p.in[3][L * 12288 + cb * 128 + tid]; }
        __syncthreads();
    }
}
__device__ __forceinline__ void phase_rowwise(const int wv_, const float* xin, const u16* y, const float* gt, const float* gpost, float* xout,
                                              const float* gpre, const float* sc, const float* sh, u16* hout) {
    const int lane = TIDX & 63, wave = TIDX >> 6;
    const int row0 = blockIdx.x * 8 + wave, rstride = gridDim.x * 8;
    f4 xn[8]; u32x2 yn[8];
#pragma unroll
    for (int i = 0; i < 8; ++i) { xn[i] = (f4){0.f, 0.f, 0.f, 0.f}; yn[i] = (u32x2){0u, 0u}; }
    if (row0 < T) {
#pragma unroll
        for (int i = 0; i < 8; ++i) { xn[i] = *(const f4*)(xin + (size_t)row0 * D + i * 256 + lane * 4); if (y != nullptr) yn[i] = *(const u32x2*)(y + (size_t)row0 * D + i * 256 + lane * 4); }
    }
    for (int row = row0; row < T; row += rstride) {
        f4 xv[8], yv[8];
#pragma unroll
        for (int i = 0; i < 8; ++i) { xv[i] = xn[i]; yv[i] = (f4){__builtin_bit_cast(float, yn[i].x << 16), __builtin_bit_cast(float, yn[i].x & 0xffff0000u), __builtin_bit_cast(float, yn[i].y << 16), __builtin_bit_cast(float, yn[i].y & 0xffff0000u)}; }
        const int nrow = row + rstride;
        if (nrow < T) {
#pragma unroll
            for (int i = 0; i < 8; ++i) { xn[i] = *(const f4*)(xin + (size_t)nrow * D + i * 256 + lane * 4); if (y != nullptr) yn[i] = *(const u32x2*)(y + (size_t)nrow * D + i * 256 + lane * 4); }
        }
        asm volatile("" ::: "memory");
        if (y != nullptr) {
            float ss = 0.f;
#pragma unroll
            for (int i = 0; i < 8; ++i) ss += yv[i][0] * yv[i][0] + yv[i][1] * yv[i][1] + yv[i][2] * yv[i][2] + yv[i][3] * yv[i][3];
            ss = wave_sum(ss); const float rs = rsqrtf(ss * (1.0f / 2048.0f) + 1e-6f);
#pragma unroll
            for (int i = 0; i < 8; ++i) { const f4 g = *(const f4*)(gpost + i * 256 + lane * 4), tt = *(const f4*)(gt + i * 256 + lane * 4); xv[i] += tt * ((yv[i] * rs) * g); }
        }
        if (xout != nullptr) {
#pragma unroll
            for (int i = 0; i < 8; ++i) *(f4*)(xout + (size_t)row * D + i * 256 + lane * 4) = xv[i];
        }
        if (hout != nullptr) {
            float ss = 0.f;
#pragma unroll
            for (int i = 0; i < 8; ++i) ss += xv[i][0] * xv[i][0] + xv[i][1] * xv[i][1] + xv[i][2] * xv[i][2] + xv[i][3] * xv[i][3];
            ss = wave_sum(ss); const float rs = rsqrtf(ss * (1.0f / 2048.0f) + 1e-6f);
#pragma unroll
            for (int i = 0; i < 8; ++i) { const f4 g = *(const f4*)(gpre + i * 256 + lane * 4), s1 = *(const f4*)(sc + i * 256 + lane * 4), s0 = *(const f4*)(sh + i * 256 + lane * 4);
                const f4 h = ((xv[i] * rs) * g) * (1.0f + s1) + s0; u32x2 w; w.x = pk_bf16(h[0], h[1]); w.y = pk_bf16(h[2], h[3]);
                *(u32x2*)(hout + (size_t)row * D + i * 256 + lane * 4) = w; }
        }
    }
}
struct EpiZ { static constexpr bool PERM = false, AFTER_DRAIN = false; float* zG; u16* zR; u16* GG;
    __device__ __forceinline__ void operator()(const f32x4 (&acc)[2][2][4][2], const pg8::Unit& u, int wr, int wc, int fr, int fq) const {
        const int row0 = u.pm * 256 + wr * 64 + fr;
        if (u.pn < 8 || u.pn == 12) { const int col0 = u.pn * 256 + wc * 32 + 4 * fq;
#pragma unroll
            for (int ai = 0; ai < 2; ++ai)
#pragma unroll
                for (int m = 0; m < 4; ++m) { float* rowp = zG + (size_t)(row0 + ai * 128 + m * 16) * NG + col0;
#pragma unroll
                    for (int bj = 0; bj < 2; ++bj)
#pragma unroll
                        for (int n = 0; n < 2; ++n) *(f32x4*)(rowp + bj * 128 + n * 16) = acc[ai][bj][m][n]; }
        } else { const bool isg = u.pn < 13;
            const int col0 = (isg ? (u.pn - 8) : (u.pn - 13)) * 256 + wc * 32 + 4 * fq; u16* const dbase = isg ? GG : zR; const int dld = isg ? 1024 : NR;
#pragma unroll
            for (int ai = 0; ai < 2; ++ai)
#pragma unroll
                for (int m = 0; m < 4; ++m) { u16* rowp = dbase + (size_t)(row0 + ai * 128 + m * 16) * dld + col0;
#pragma unroll
                    for (int bj = 0; bj < 2; ++bj)
#pragma unroll
                        for (int n = 0; n < 2; ++n) { const f32x4 v = acc[ai][bj][m][n]; u32x2 w; w.x = pk_bf16(v[0], v[1]); w.y = pk_bf16(v[2], v[3]); *(u32x2*)(rowp + bj * 128 + n * 16) = w; } }
        }
    } };
struct EpiPlain { static constexpr bool PERM = false, AFTER_DRAIN = false; float* C; int ldc;
    __device__ __forceinline__ void operator()(const f32x4 (&acc)[2][2][4][2], const pg8::Unit& u, int wr, int wc, int fr, int fq) const {
        const int row0 = u.pm * 256 + wr * 64 + fr, col0 = u.pn * 256 + wc * 32 + 4 * fq;
#pragma unroll
        for (int ai = 0; ai < 2; ++ai)
#pragma unroll
            for (int m = 0; m < 4; ++m) { float* rowp = C + (size_t)(row0 + ai * 128 + m * 16) * ldc + col0;
#pragma unroll
                for (int bj = 0; bj < 2; ++bj)
#pragma unroll
                    for (int n = 0; n < 2; ++n) *(f32x4*)(rowp + bj * 128 + n * 16) = acc[ai][bj][m][n]; }
    } };
struct EpiBf16 { static constexpr bool PERM = false, AFTER_DRAIN = false; u16* O; int ldc;
    __device__ __forceinline__ void operator()(const f32x4 (&acc)[2][2][4][2], const pg8::Unit& u, int wr, int wc, int fr, int fq) const {
        const int row0 = u.pm * 256 + wr * 64 + fr, col0 = u.pn * 256 + wc * 32 + 4 * fq;
#pragma unroll
        for (int ai = 0; ai < 2; ++ai)
#pragma unroll
            for (int m = 0; m < 4; ++m) { u16* rowp = O + (size_t)(row0 + ai * 128 + m * 16) * ldc + col0;
#pragma unroll
                for (int bj = 0; bj < 2; ++bj)
#pragma unroll
                    for (int n = 0; n < 2; ++n) { const f32x4 v = acc[ai][bj][m][n]; u32x2 w; w.x = pk_bf16(v[0], v[1]); w.y = pk_bf16(v[2], v[3]); *(u32x2*)(rowp + bj * 128 + n * 16) = w; } }
    } };
struct EpiRelu2 { static constexpr bool PERM = false, AFTER_DRAIN = false; u16* O; int ldc;
    __device__ __forceinline__ void operator()(const f32x4 (&acc)[2][2][4][2], const pg8::Unit& u, int wr, int wc, int fr, int fq) const {
        const int row0 = u.pm * 256 + wr * 64 + fr, col0 = u.pn * 256 + wc * 32 + 4 * fq;
#pragma unroll
        for (int ai = 0; ai < 2; ++ai)
#pragma unroll
            for (int m = 0; m < 4; ++m) { u16* rowp = O + (size_t)(row0 + ai * 128 + m * 16) * ldc + col0;
#pragma unroll
                for (int bj = 0; bj < 2; ++bj)
#pragma unroll
                    for (int n = 0; n < 2; ++n) { f32x4 v = acc[ai][bj][m][n];
                        v[0] = fmaxf(v[0], 0.f); v[1] = fmaxf(v[1], 0.f); v[2] = fmaxf(v[2], 0.f); v[3] = fmaxf(v[3], 0.f); v = v * v;
                        u32x2 w; w.x = pk_bf16(v[0], v[1]); w.y = pk_bf16(v[2], v[3]); *(u32x2*)(rowp + bj * 128 + n * 16) = w; } }
    } };
#define EPI_LOOP_BEGIN const int row0 = u.pm * 256 + wr * 64 + fr, col0 = u.pn * 256 + wc * 32 + 4 * fq; \
        _Pragma("unroll") for (int ai = 0; ai < 2; ++ai) _Pragma("unroll") for (int m = 0; m < 4; ++m) { _Pragma("unroll") for (int bj = 0; bj < 2; ++bj) _Pragma("unroll") for (int n = 0; n < 2; ++n) { \
            const int cl = col0 + bj * 128 + n * 16; const size_t idx = (size_t)(row0 + ai * 128 + m * 16) * 1024 + cl; const f32x4 a = acc[ai][bj][m][n];
#define EPI_LOOP_END asm volatile("" ::: "memory"); } }
struct EpiGen4 { static constexpr bool PERM = false, AFTER_DRAIN = false; float* O0; float* O1; float* O2; float* O3; const float* b0p; const float* b1p; const float* b3p; const float* V0;
    __device__ __forceinline__ void operator()(const f32x4 (&acc)[2][2][4][2], const pg8::Unit& u, int wr, int wc, int fr, int fq) const {
        const int region = u.pn >> 2;
        float* O = O0; const float* bias = b0p; int mode = 2;
        if (launder_s(region) == 1) { O = O1; bias = b1p; mode = 1; }
        if (launder_s(region) == 2) { O = O2; mode = 0; }
        if (launder_s(region) == 3) { O = O3; bias = b3p; mode = 3; }
        const int row0 = u.pm * 256 + wr * 64 + fr, col0 = (u.pn & 3) * 256 + wc * 32 + 4 * fq;
#pragma unroll
        for (int ai = 0; ai < 2; ++ai)
#pragma unroll
            for (int m = 0; m < 4; ++m) {
#pragma unroll
                for (int bj = 0; bj < 2; ++bj)
#pragma unroll
                    for (int n = 0; n < 2; ++n) { const int cl = col0 + bj * 128 + n * 16; const size_t idx = (size_t)(row0 + ai * 128 + m * 16) * 1024 + cl; const f32x4 a = acc[ai][bj][m][n];
                        f32x4 o = a;
                        if (mode != 0) { const f32x4 bb = *(const f32x4*)(bias + cl);
#pragma unroll
                            for (int q = 0; q < 4; ++q) o[q] = sigm(bb[q] + a[q]);
                            if (mode == 2) {
#pragma unroll
                                for (int q = 0; q < 4; ++q) o[q] = __expf(-0.60653065971f * o[q]);
                            } else if (mode == 3) { const f32x4 vr = *(const f32x4*)(O + idx), vf = *(const f32x4*)(V0 + idx);
#pragma unroll
                                for (int q = 0; q < 4; ++q) o[q] = vr[q] + (vf[q] - vr[q]) * o[q]; } }
                        if (mode == 0) { u32x2 w; w.x = pk_bf16(o[0], o[1]); w.y = pk_bf16(o[2], o[3]); *(u32x2*)((u16*)O + idx) = w; }
                        else *(f32x4*)(O + idx) = o;
                        asm volatile("" ::: "memory"); } }
    } };
struct EpiGen { static constexpr bool PERM = false, AFTER_DRAIN = false; float* O; const float* bias; const float* V0; int mode;
    __device__ __forceinline__ void operator()(const f32x4 (&acc)[2][2][4][2], const pg8::Unit& u, int wr, int wc, int fr, int fq) const {
        EPI_LOOP_BEGIN
            f32x4 o = a;
            if (mode != 0) { const f32x4 b0 = *(const f32x4*)(bias + cl);
#pragma unroll
                for (int q = 0; q < 4; ++q) o[q] = sigm(b0[q] + a[q]);
                if (mode == 2) {
#pragma unroll
                    for (int q = 0; q < 4; ++q) o[q] = __expf(-0.60653065971f * o[q]);
                } else if (mode == 3) { const f32x4 vr = *(const f32x4*)(O + idx), vf = *(const f32x4*)(V0 + idx);
#pragma unroll
                    for (int q = 0; q < 4; ++q) o[q] = vr[q] + (vf[q] - vr[q]) * o[q]; } }
            *(f32x4*)(O + idx) = o;
        EPI_LOOP_END
    } };
__device__ __forceinline__ void phase_prep(const int wv_, const Params& p, int L) {
    const int tid = TIDX;
    unsigned char* ws = launder_p(p.ws);
    const float* zG = (const float*)(ws + WS_ZG); const u16* zR = (const u16*)(ws + WS_ZR);
    float* R = (float*)(ws + WS_R); float* K = (float*)(ws + WS_K); float* A = (float*)(ws + WS_A);
    float* Vd = (float*)(ws + (L == 0 ? WS_V0 : WS_V1)); float* ALPHA = (float*)(ws + WS_ALPHA);
    u16* Acat1 = (u16*)(ws + WS_ACAT1); u16* Acat2 = (u16*)(ws + WS_ACAT2);
    for (int tile = blockIdx.x; tile < T / 8; tile += gridDim.x) {
        const int t0 = tile * 8;
#pragma unroll
        for (int pass = 0; pass < 2; ++pass) {
            const int c4 = pass * 512 + tid;
            if (c4 < 896) {
                const int col = c4 * 4;
                f4 mu; if (col < 3520) mu = *(const f4*)(p.in[12] + L * 3520 + col); else if (L == 1) mu = *(const f4*)(p.in[24] + col - 3520); else mu = (f4){0.f, 0.f, 0.f, 0.f};
                f4 z[9]; u32x2 zb[9];
                zb[0] = (t0 > 0) ? *(const u32x2*)(zR + (size_t)(t0 - 1) * NR + col) : (u32x2){0u, 0u};
#pragma unroll
                for (int i = 0; i < 8; ++i) zb[i + 1] = *(const u32x2*)(zR + (size_t)(t0 + i) * NR + col);
#pragma unroll
                for (int i = 0; i < 9; ++i) z[i] = (f4){__builtin_bit_cast(float, zb[i].x << 16), __builtin_bit_cast(float, zb[i].x & 0xffff0000u), __builtin_bit_cast(float, zb[i].y << 16), __builtin_bit_cast(float, zb[i].y & 0xffff0000u)};
                f4 kkw = (f4){0.f, 0.f, 0.f, 0.f}; if (pass == 0 && tid >= 256) kkw = *(const f4*)(p.in[18] + L * 1024 + col - 1024);
#pragma unroll
                for (int i = 0; i < 8; ++i) {
                    const f4 zl = z[i + 1] + mu * (z[i] - z[i + 1]); const size_t t = (size_t)(t0 + i);
                    if (pass == 0) {
                        if (tid < 256) { u32x2 wr_; wr_.x = pk_bf16(zl[0], zl[1]); wr_.y = pk_bf16(zl[2], zl[3]); *(u32x2*)((u16*)R + t * 1024 + col) = wr_; }
                        else { const f4 kv = zl * kkw; const float ss = red16(kv[0] * kv[0] + kv[1] * kv[1] + kv[2] * kv[2] + kv[3] * kv[3]);
                               const float rn = rsqrtf(fmaxf(ss, 1e-24f)); *(f4*)(K + t * 1024 + col - 1024) = zl; *(f4*)(A + t * 1024 + col - 1024) = -(kv * rn); }
                    } else {
                        if (tid < 256) *(f4*)(Vd + t * 1024 + col - 2048) = zl;
                        else { float o0, o1, o2, o3; u16* dst;
                            if (tid < 280)      { o0 = tanhf(zl[0]); o1 = tanhf(zl[1]); o2 = tanhf(zl[2]); o3 = tanhf(zl[3]); dst = Acat1 + t * 256 + (col - 3072); }
                            else if (tid < 304) { o0 = zl[0]; o1 = zl[1]; o2 = zl[2]; o3 = zl[3]; dst = Acat1 + t * 256 + (col - 3072); }
                            else if (tid < 368) { o0 = sigm(zl[0]); o1 = sigm(zl[1]); o2 = sigm(zl[2]); o3 = sigm(zl[3]); dst = Acat2 + t * 256 + (col - 3264); }
                            else                { const float m1 = (L == 1) ? 1.f : 0.f; o0 = zl[0] * m1; o1 = zl[1] * m1; o2 = zl[2] * m1; o3 = zl[3] * m1; dst = Acat1 + t * 256 + 192 + (col - 3520); }
                            u32x2 w; w.x = pk_bf16(o0, o1); w.y = pk_bf16(o2, o3); *(u32x2*)dst = w; }
                    }
                }
            }
        }
    }
    { const int lane = tid & 63, wave = tid >> 6; const int c0 = lane * 8;
      f4 wa0[16], wa1[16];
#pragma unroll
      for (int r = 0; r < 16; ++r) { wa0[r] = *(const f4*)(p.in[9] + (size_t)L * 16 * 512 + r * 512 + c0); wa1[r] = *(const f4*)(p.in[9] + (size_t)L * 16 * 512 + r * 512 + c0 + 4); }
      const f4 ba0 = *(const f4*)(p.in[10] + L * 512 + c0), ba1 = *(const f4*)(p.in[10] + L * 512 + c0 + 4);
#pragma unroll 1
      for (int t = blockIdx.x * 8 + wave; t < T; t += gridDim.x * 8) {
          const float* al = zG + (size_t)t * NG + 3072;
          const f4 l0 = *(const f4*)(al), l1 = *(const f4*)(al + 4), l2 = *(const f4*)(al + 8), l3 = *(const f4*)(al + 12);
          const float lv[16] = {l0[0], l0[1], l0[2], l0[3], l1[0], l1[1], l1[2], l1[3], l2[0], l2[1], l2[2], l2[3], l3[0], l3[1], l3[2], l3[3]};
          f4 a0 = ba0, a1 = ba1;
#pragma unroll
          for (int r = 0; r < 16; ++r) { a0 += lv[r] * wa0[r]; a1 += lv[r] * wa1[r]; }
          f4 o0, o1;
#pragma unroll
          for (int q = 0; q < 4; ++q) { const float x0 = a0[q], x1 = a1[q];
              o0[q] = expf((fminf(x0, 0.f) - log1pf(expf(-fabsf(x0)))) * (1.0f / 16.0f)); o1[q] = expf((fminf(x1, 0.f) - log1pf(expf(-fabsf(x1)))) * (1.0f / 16.0f)); }
          *(f4*)(ALPHA + (size_t)t * 512 + c0) = o0; *(f4*)(ALPHA + (size_t)t * 512 + c0 + 4) = o1; } }
}
struct ScanSrc { const float* b0; const float* b1; const float* b2; const float* b3; const float* b4; const float* b5; int ld0, ld1, ld2, ld3, ld4, ld5; };
template <bool RW, bool WY>
__device__ __forceinline__ void scan_run(const int wv_, float* ldsw, const ScanSrc& S, int t0, int nsteps, f2 (&s)[8][4], f2 (&pd)[4], const f2 (&ka2)[4], float vks, u16* yout, int ldy, float yscale, bool active = true, const f2* rk2 = nullptr, float* bdout = nullptr) {
    const int lane = TIDX & 63, j = lane & 7, g = lane >> 3, lrow = lane >> 4, lcol = (lane & 15) * 4;
    if (!active) return;
    f4 pre0, pre1, pre2, pre3, pre4, pre5;
#define SCAN_LOAD(tb) do { const size_t rr = (size_t)((tb) + lrow); \
        pre0 = *(const f4*)(S.b0 + rr * S.ld0 + lcol); pre3 = *(const f4*)(S.b3 + rr * S.ld3 + lcol); pre5 = *(const f4*)(S.b5 + rr * S.ld5 + lcol); \
        if (WY) { if (RW) { const u32x2 w4_ = *(const u32x2*)((const u16*)S.b4 + rr * S.ld4 + lcol); pre4 = (f4){__builtin_bit_cast(float, w4_.x << 16), __builtin_bit_cast(float, w4_.x & 0xffff0000u), __builtin_bit_cast(float, w4_.y << 16), __builtin_bit_cast(float, w4_.y & 0xffff0000u)}; } else pre4 = *(const f4*)(S.b4 + rr * S.ld4 + lcol); } \
        if (RW) { pre1 = *(const f4*)(S.b1 + rr * S.ld1 + lcol); pre2 = *(const f4*)(S.b2 + rr * S.ld2 + lcol); } } while (0)
    const int nblk = nsteps >> 2;
    SCAN_LOAD(t0);
#pragma unroll 1
    for (int blk = 0; blk < nblk; ++blk) {
        asm volatile("s_waitcnt lgkmcnt(0)" ::: "memory");
        { float* d = ldsw + lrow * 64 + lcol;
            *(f4*)(d + 0 * 256) = pre0; *(f4*)(d + 3 * 256) = pre3; *(f4*)(d + 5 * 256) = pre5;
            if (WY) *(f4*)(d + 4 * 256) = pre4;
            if (RW) { *(f4*)(d + 1 * 256) = pre1; *(f4*)(d + 2 * 256) = pre2; } }
        asm volatile("s_waitcnt lgkmcnt(0)" ::: "memory");
        if (blk + 1 < nblk) SCAN_LOAD(t0 + (blk + 1) * 4);
#pragma unroll 1
        for (int st = 0; st < 4; ++st) {
            const float* Lp = ldsw + st * 64;
            const f4 wA = *(const f4*)(Lp + 0 * 256 + j * 8), wB = *(const f4*)(Lp + 0 * 256 + j * 8 + 4);
            const f4 kA = *(const f4*)(Lp + 3 * 256 + j * 8), kB = *(const f4*)(Lp + 3 * 256 + j * 8 + 4);
            const f4 vA = *(const f4*)(Lp + 5 * 256 + g * 8), vB = *(const f4*)(Lp + 5 * 256 + g * 8 + 4);
            f4 aA, aB, bA, bB, rA, rB;
            if (RW) { aA = *(const f4*)(Lp + 1 * 256 + j * 8); aB = *(const f4*)(Lp + 1 * 256 + j * 8 + 4); bA = *(const f4*)(Lp + 2 * 256 + j * 8); bB = *(const f4*)(Lp + 2 * 256 + j * 8 + 4); }
            if (WY) { rA = *(const f4*)(Lp + 4 * 256 + j * 8); rB = *(const f4*)(Lp + 4 * 256 + j * 8 + 4); }
            const f2 w2[4] = {(f2){wA[0], wA[1]}, (f2){wA[2], wA[3]}, (f2){wB[0], wB[1]}, (f2){wB[2], wB[3]}};
            f2 k2[4] = {(f2){kA[0], kA[1]}, (f2){kA[2], kA[3]}, (f2){kB[0], kB[1]}, (f2){kB[2], kB[3]}};
            f2 a2[4], b2[4], r2[4];
            if (RW) { a2[0] = (f2){aA[0], aA[1]}; a2[1] = (f2){aA[2], aA[3]}; a2[2] = (f2){aB[0], aB[1]}; a2[3] = (f2){aB[2], aB[3]};
                      b2[0] = (f2){bA[0], bA[1]}; b2[1] = (f2){bA[2], bA[3]}; b2[2] = (f2){bB[0], bB[1]}; b2[3] = (f2){bB[2], bB[3]};
#pragma unroll
                      for (int q = 0; q < 4; ++q) { k2[q] = k2[q] * (b2[q] * ka2[q] + (1.0f - ka2[q])); b2[q] = -(a2[q] * b2[q]); } }
            if (WY) { r2[0] = (f2){rA[0], rA[1]}; r2[1] = (f2){rA[2], rA[3]}; r2[2] = (f2){rB[0], rB[1]}; r2[3] = (f2){rB[2], rB[3]}; }
            const float vv[8] = {vA[0], vA[1], vA[2], vA[3], vB[0], vB[1], vB[2], vB[3]};
            float ysel = 0.f;
            if (RW) {
                float d[8];
#pragma unroll
                for (int i = 0; i < 8; ++i) { f2 d2 = s[i][0] * a2[0]; d2 += s[i][1] * a2[1]; d2 += s[i][2] * a2[2]; d2 += s[i][3] * a2[3]; d[i] = d2[0] + d2[1]; }
#pragma unroll
                for (int i = 0; i < 8; ++i) d[i] += dppf<0xB1>(d[i]);
#pragma unroll
                for (int i = 0; i < 8; ++i) d[i] += dppf<0x4E>(d[i]);
#pragma unroll
                for (int i = 0; i < 8; ++i) d[i] += dppf<0x141>(d[i]);
#pragma unroll
                for (int i = 0; i < 8; ++i) { const float vi = vv[i] * vks;
#pragma unroll
                    for (int q = 0; q < 4; ++q) s[i][q] = s[i][q] * w2[q] + (d[i] * b2[q] + vi * k2[q]); }
            } else {
#pragma unroll
                for (int i = 0; i < 8; ++i) { const float vi = vv[i] * vks;
#pragma unroll
                    for (int q = 0; q < 4; ++q) s[i][q] = s[i][q] * w2[q] + vi * k2[q]; }
            }
            if (WY) {
                float y[8];
#pragma unroll
                for (int i = 0; i < 8; ++i) { f2 y2 = s[i][0] * r2[0]; y2 += s[i][1] * r2[1]; y2 += s[i][2] * r2[2]; y2 += s[i][3] * r2[3]; y[i] = y2[0] + y2[1]; }
#pragma unroll
                for (int i = 0; i < 8; ++i) y[i] += dppf<0xB1>(y[i]);
#pragma unroll
                for (int i = 0; i < 8; ++i) y[i] += dppf<0x4E>(y[i]);
#pragma unroll
                for (int i = 0; i < 8; ++i) y[i] += dppf<0x141>(y[i]);
#pragma unroll
                for (int i = 0; i < 8; ++i) ysel = (j == i) ? y[i] : ysel;
            }
            if (!RW) {
#pragma unroll
                for (int q = 0; q < 4; ++q) pd[q] *= w2[q];
            }
            if (WY) yout[(size_t)(t0 + blk * 4 + st) * ldy + lane] = to_bf16(ysel * yscale);
            if (RW && WY) {
                f2 bb = (r2[0] * k2[0]) * rk2[0]; bb += (r2[1] * k2[1]) * rk2[1]; bb += (r2[2] * k2[2]) * rk2[2]; bb += (r2[3] * k2[3]) * rk2[3];
                const float bsum = red8(bb[0] + bb[1]);
                if (lane == 0) bdout[(size_t)(t0 + blk * 4 + st) * 16] = bsum; }
        }
    }
#undef SCAN_LOAD
}
template <bool RW, bool VK>
__device__ __forceinline__ void scan_run_ring(const int wv_, float* ldsw  , const ScanSrc& S, int t0, int nsteps, f2 (&s)[8][4], f2 (&pd)[4], const f2 (&ka2)[4], float vks) {
    const int lane = TIDX & 63, j = lane & 7, g = lane >> 3, lrow = lane >> 4, lcol = (lane & 15) * 4;
    const int nblk = nsteps >> 2;
    LAS unsigned char* l3 = (LAS unsigned char*)ldsw;
#define RING_ISSUE(bb) do { const int b_ = ((bb) < nblk) ? (bb) : (nblk - 1); const size_t rr = (size_t)(t0 + b_ * 4 + lrow); LAS unsigned char* dst_ = l3 + ((bb) % 3) * 6144; \
        __builtin_amdgcn_global_load_lds((const unsigned*)(S.b0 + rr * S.ld0 + lcol), (LAS unsigned*)(dst_ + 0 * 1024), 16, 0, 0); \
        __builtin_amdgcn_global_load_lds((const unsigned*)(S.b1 + rr * S.ld1 + lcol), (LAS unsigned*)(dst_ + 1 * 1024), 16, 0, 0); \
        __builtin_amdgcn_global_load_lds((const unsigned*)(S.b2 + rr * S.ld2 + lcol), (LAS unsigned*)(dst_ + 2 * 1024), 16, 0, 0); \
        __builtin_amdgcn_global_load_lds((const unsigned*)(S.b3 + rr * S.ld3 + lcol), (LAS unsigned*)(dst_ + 3 * 1024), 16, 0, 0); \
        __builtin_amdgcn_global_load_lds((const unsigned*)(S.b5 + rr * S.ld5 + lcol), (LAS unsigned*)(dst_ + 5 * 1024), 16, 0, 0); } while (0)
    RING_ISSUE(0); RING_ISSUE(1);
#pragma unroll 1
    for (int blk = 0; blk < nblk; ++blk) {
        asm volatile("s_waitcnt lgkmcnt(0)" ::: "memory");
        RING_ISSUE(blk + 2);
        asm volatile("s_waitcnt vmcnt(10)" ::: "memory");
        const float* Lb = ldsw + (blk % 3) * 1536;
#pragma unroll 1
        for (int st = 0; st < 4; ++st) {
            const float* Lp = Lb + st * 64;
            const f4 wA = *(const f4*)(Lp + 0 * 256 + j * 8), wB = *(const f4*)(Lp + 0 * 256 + j * 8 + 4);
            const f4 kA = *(const f4*)(Lp + 3 * 256 + j * 8), kB = *(const f4*)(Lp + 3 * 256 + j * 8 + 4);
            const f4 vA = *(const f4*)(Lp + 5 * 256 + g * 8), vB = *(const f4*)(Lp + 5 * 256 + g * 8 + 4);
            const f2 w2[4] = {(f2){wA[0], wA[1]}, (f2){wA[2], wA[3]}, (f2){wB[0], wB[1]}, (f2){wB[2], wB[3]}};
            f2 k2[4] = {(f2){kA[0], kA[1]}, (f2){kA[2], kA[3]}, (f2){kB[0], kB[1]}, (f2){kB[2], kB[3]}};
            const float vv[8] = {vA[0], vA[1], vA[2], vA[3], vB[0], vB[1], vB[2], vB[3]};
            if (RW) {
                const f4 aA = *(const f4*)(Lp + 1 * 256 + j * 8), aB = *(const f4*)(Lp + 1 * 256 + j * 8 + 4), bA = *(const f4*)(Lp + 2 * 256 + j * 8), bB = *(const f4*)(Lp + 2 * 256 + j * 8 + 4);
                const f2 a2[4] = {(f2){aA[0], aA[1]}, (f2){aA[2], aA[3]}, (f2){aB[0], aB[1]}, (f2){aB[2], aB[3]}};
                f2 b2[4] = {(f2){bA[0], bA[1]}, (f2){bA[2], bA[3]}, (f2){bB[0], bB[1]}, (f2){bB[2], bB[3]}};
#pragma unroll
                for (int q = 0; q < 4; ++q) { if (VK) k2[q] = k2[q] * (b2[q] * ka2[q] + (1.0f - ka2[q])); b2[q] = -(a2[q] * b2[q]); }
                float d[8];
#pragma unroll
                for (int i = 0; i < 8; ++i) { f2 d2 = s[i][0] * a2[0]; d2 += s[i][1] * a2[1]; d2 += s[i][2] * a2[2]; d2 += s[i][3] * a2[3]; d[i] = d2[0] + d2[1]; }
#pragma unroll
                for (int i = 0; i < 8; ++i) d[i] += dppf<0xB1>(d[i]);
#pragma unroll
                for (int i = 0; i < 8; ++i) d[i] += dppf<0x4E>(d[i]);
#pragma unroll
                for (int i = 0; i < 8; ++i) d[i] += dppf<0x141>(d[i]);
#pragma unroll
                for (int i = 0; i < 8; ++i) { const float vi = vv[i] * vks;
#pragma unroll
                    for (int q = 0; q < 4; ++q) { if (VK) s[i][q] = s[i][q] * w2[q] + (d[i] * b2[q] + vi * k2[q]); else s[i][q] = s[i][q] * w2[q] + d[i] * b2[q]; } }
            } else {
#pragma unroll
                for (int i = 0; i < 8; ++i) { const float vi = vv[i] * vks;
#pragma unroll
                    for (int q = 0; q < 4; ++q) s[i][q] = s[i][q] * w2[q] + vi * k2[q]; }
#pragma unroll
                for (int q = 0; q < 4; ++q) pd[q] *= w2[q];
            }
        }
    }
    asm volatile("s_waitcnt vmcnt(0)" ::: "memory");
#undef RING_ISSUE
}
__device__ __forceinline__ ScanSrc rwkv_src(unsigned char* ws, int L, int h) {
    ScanSrc S; S.b0 = (const float*)(ws + WS_W) + h * 64; S.b1 = (const float*)(ws + WS_A) + h * 64; S.b2 = (const float*)(ws + WS_B) + h * 64; S.b3 = (const float*)(ws + WS_K) + h * 64;
    S.b4 = (const float*)((const u16*)(ws + WS_R) + h * 64);     S.b5 = (const float*)(ws + (L == 0 ? WS_V0 : WS_V1)) + h * 64; S.ld0 = S.ld1 = S.ld2 = S.ld3 = S.ld4 = S.ld5 = 1024; return S;
}
__device__ __forceinline__ ScanSrc gla_src(unsigned char* ws, int hd, int half) {
    const float* zG = (const float*)(ws + WS_ZG);
    ScanSrc S; S.b0 = (const float*)(ws + WS_ALPHA) + hd * 64; S.ld0 = 512; S.b1 = S.b0; S.b2 = S.b0; S.ld1 = S.ld2 = 512;
    S.b3 = zG + 512 + hd * 64; S.ld3 = NG; S.b4 = zG + hd * 64; S.ld4 = NG; S.b5 = zG + 1024 + hd * 128 + half * 64; S.ld5 = NG; return S;
}
__device__ __forceinline__ void state_store(const int wv_, float* dst  , const f2 (&s)[8][4]) {
    const int lane = TIDX & 63, j = lane & 7, g = lane >> 3;
#pragma unroll
    for (int i = 0; i < 8; ++i) { float* d = dst + (size_t)(g * 8 + i) * 64 + j * 8;
        *(f4*)(d) = (f4){s[i][0][0], s[i][0][1], s[i][1][0], s[i][1][1]}; *(f4*)(d + 4) = (f4){s[i][2][0], s[i][2][1], s[i][3][0], s[i][3][1]}; }
}
__device__ __forceinline__ void state_load(const int wv_, const float* src, f2 (&s)[8][4]) {
    const int lane = TIDX & 63, j = lane & 7, g = lane >> 3;
#pragma unroll
    for (int i = 0; i < 8; ++i) { const float* d = src + (size_t)(g * 8 + i) * 64 + j * 8; const f4 x = *(const f4*)(d), y = *(const f4*)(d + 4);
        s[i][0] = (f2){x[0], x[1]}; s[i][1] = (f2){x[2], x[3]}; s[i][2] = (f2){y[0], y[1]}; s[i][3] = (f2){y[2], y[3]}; }
}
__device__ __forceinline__ void phase_scan1(const int wv_, const Params& p, int L, float* ldsf) {
    unsigned char* ws = launder_p(p.ws);
    const int wave = __builtin_amdgcn_readfirstlane(TIDX >> 6), lane = TIDX & 63, j = lane & 7, g = lane >> 3;
    float* ldsw = ldsf + wave * 4608;
    for (int tb = blockIdx.x; tb < 252; tb += gridDim.x) {
        f2 s[8][4]; f2 pd[4];
#pragma unroll
        for (int q = 0; q < 4; ++q) pd[q] = (f2){1.f, 1.f};
        const bool isM = wave >= 4; const int idx = tb * 4 + (wave & 3); const int h = idx / 63, c = idx % 63;
#pragma unroll
        for (int i = 0; i < 8; ++i)
#pragma unroll
            for (int q = 0; q < 4; ++q) { const int e = j * 8 + q * 2, r = g * 8 + i; s[i][q] = (f2){(isM && e == r) ? 1.f : 0.f, (isM && e + 1 == r) ? 1.f : 0.f}; }
        const ScanSrc S = rwkv_src(ws, L, h);
        f2 ka2[4]; { const float* kp = p.in[19] + L * 1024 + h * 64 + j * 8; const f4 x = *(const f4*)(kp), y = *(const f4*)(kp + 4); ka2[0] = (f2){x[0], x[1]}; ka2[1] = (f2){x[2], x[3]}; ka2[2] = (f2){y[0], y[1]}; ka2[3] = (f2){y[2], y[3]}; }
        if (isM) scan_run_ring<true, false>(wv_, ldsw, S, c * 128, 128, s, pd, ka2, 0.f); else scan_run_ring<true, true>(wv_, ldsw, S, c * 128, 128, s, pd, ka2, 1.f);
        if (isM) { float* mt = (float*)(ws + WS_MB) + (size_t)(h * 64 + c) * 4096;
#pragma unroll
            for (int i = 0; i < 8; ++i)
#pragma unroll
                for (int q = 0; q < 4; ++q) { mt[(size_t)(j * 8 + q * 2) * 64 + g * 8 + i] = s[i][q][0]; mt[(size_t)(j * 8 + q * 2 + 1) * 64 + g * 8 + i] = s[i][q][1]; } }
        else state_store(wv_, (float*)(ws + WS_NB) + (size_t)(h * 64 + c) * 4096, s);
    }
    for (int tb = blockIdx.x; tb < 252; tb += gridDim.x) {
        f2 s[8][4]; f2 pd[4];
#pragma unroll
        for (int q = 0; q < 4; ++q) pd[q] = (f2){1.f, 1.f};
        const bool active = wave < 4;
        const int idx = tb * 4 + (wave & 3); const int hh = idx / 63, c = idx % 63, hd = hh >> 1, half = hh & 1;
#pragma unroll
        for (int i = 0; i < 8; ++i)
#pragma unroll
            for (int q = 0; q < 4; ++q) s[i][q] = (f2){0.f, 0.f};
        const ScanSrc S = gla_src(ws, hd, half); const f2 pd0[4] = {(f2){1.f, 1.f}, (f2){1.f, 1.f}, (f2){1.f, 1.f}, (f2){1.f, 1.f}};
        if (active) scan_run_ring<false, true>(wv_, ldsw, S, c * 128, 128, s, pd, pd0, 1.f);
        if (active) {
            state_store(wv_, (float*)(ws + WS_NGB) + ((size_t)(hd * 64 + c) * 128 + half * 64) * 64, s);
            if (half == 0 && g == 0) { float* d = (float*)(ws + WS_PGB) + (size_t)(hd * 64 + c) * 64 + j * 8;
                *(f4*)(d) = (f4){pd[0][0], pd[0][1], pd[1][0], pd[1][1]}; *(f4*)(d + 4) = (f4){pd[2][0], pd[2][1], pd[3][0], pd[3][1]}; }
        }
    }
}
__device__ __forceinline__ void phase_scan2(const int wv_, const Params& p, float* ldsM) {
    unsigned char* ws = launder_p(p.ws); const int tid = TIDX, lane = tid & 63, wave = tid >> 6;
    const float* MB = (const float*)(ws + WS_MB); const float* NB = (const float*)(ws + WS_NB); float* SB = (float*)(ws + WS_SB);
    const float* NGB = (const float*)(ws + WS_NGB); const float* PGB = (const float*)(ws + WS_PGB); float* SGB = (float*)(ws + WS_SGB);
    { const int q = blockIdx.x;
        if (q < 128) {
            const int h = (q & 7) + 8 * (q >> 6), r = ((q >> 3) & 7) * 8 + wave;
            f4 mr[16]; float nr[8]; float s = 0.f;
#pragma unroll
            for (int i = 0; i < 16; ++i) mr[i] = (f4){0.f, 0.f, 0.f, 0.f};
#pragma unroll
            for (int i = 0; i < 8; ++i) nr[i] = 0.f;
#define P2_LOADB(bb) do { const int c0_ = (bb) * 8; \
                _Pragma("unroll") for (int i = 0; i < 16; ++i) { const int m_ = i >> 1; const int cc_ = (c0_ + m_ < 63) ? c0_ + m_ : 62; mr[i] = *(const f4*)(MB + (size_t)(h * 64 + cc_) * 4096 + (i & 1) * 2048 + tid * 4); } \
                _Pragma("unroll") for (int m_ = 0; m_ < 8; ++m_) { const int cc_ = (c0_ + m_ < 63) ? c0_ + m_ : 62; nr[m_] = NB[((size_t)(h * 64 + cc_) * 64 + r) * 64 + lane]; } } while (0)
            P2_LOADB(0);
#pragma unroll 1
            for (int b = 0; b < 8; ++b) {
                __syncthreads();
#pragma unroll
                for (int i = 0; i < 16; ++i) { const int x = (i & 1) * 2048 + tid * 4; *(f4*)(ldsM + (i >> 1) * 4352 + (x >> 6) * 68 + (x & 63)) = mr[i]; }
                float nv[8];
#pragma unroll
                for (int m = 0; m < 8; ++m) nv[m] = nr[m];
                __syncthreads();
                P2_LOADB((b + 1 < 8) ? b + 1 : 7);
                float* sv = ldsM + 8 * 4352 + wave * 64;
#pragma unroll
                for (int m = 0; m < 8; ++m) { const int cc = b * 8 + m;
                    if (cc < 63) {
                        sv[lane] = s;
                        asm volatile("s_waitcnt lgkmcnt(0)" ::: "memory");
                        const float* Mrow = ldsM + m * 4352 + lane * 68;
                        f4 a4 = (f4){nv[m], 0.f, 0.f, 0.f};
#pragma unroll
                        for (int kh = 0; kh < 16; kh += 8) { f4 mq[8], sq[8];
#pragma unroll
                            for (int k4 = 0; k4 < 8; ++k4) { mq[k4] = *(const f4*)(Mrow + (kh + k4) * 4); sq[k4] = *(const f4*)(sv + (kh + k4) * 4); }
#pragma unroll
                            for (int k4 = 0; k4 < 8; ++k4) a4 += mq[k4] * sq[k4];
                            asm volatile("" ::: "memory"); }
                        s = (a4[0] + a4[1]) + (a4[2] + a4[3]);
                        SB[((size_t)(h * 64 + cc + 1) * 64 + r) * 64 + lane] = s; }
                    asm volatile("" ::: "memory"); }
            }
#undef P2_LOADB
        } else if (q < 256) {
            const int idx = (q - 128) * 512 + tid; const int hd = idx >> 13, row = (idx >> 6) & 127, e = idx & 63;
            float s = 0.f;
#pragma unroll 1
            for (int cb = 0; cb < 63; cb += 9) { float pv[9], nv[9];
#pragma unroll
                for (int i = 0; i < 9; ++i) { pv[i] = PGB[(size_t)(hd * 64 + cb + i) * 64 + e]; nv[i] = NGB[((size_t)(hd * 64 + cb + i) * 128 + row) * 64 + e]; }
                asm volatile("" ::: "memory");
#pragma unroll
                for (int i = 0; i < 9; ++i) { s = pv[i] * s + nv[i]; SGB[((size_t)(hd * 64 + cb + i + 1) * 128 + row) * 64 + e] = s; } }
        }
    }
}
__device__ __forceinline__ void phase_scan3(const int wv_, const Params& p, int L, float* ldsf) {
    unsigned char* ws = launder_p(p.ws);
    const int wave = __builtin_amdgcn_readfirstlane(TIDX >> 6);
    float* ldsw = ldsf + wave * 1536;
    for (int tb = blockIdx.x; tb < 256; tb += gridDim.x) {
        f2 s[8][4]; f2 pd[4];
#pragma unroll
        for (int q = 0; q < 4; ++q) pd[q] = (f2){1.f, 1.f};
#pragma unroll
        for (int i = 0; i < 8; ++i)
#pragma unroll
            for (int q = 0; q < 4; ++q) s[i][q] = (f2){0.f, 0.f};
        if (wave < 4) {
            const int idx = tb * 4 + wave; const int h = idx >> 6, c = idx & 63;
            if (c > 0) state_load(wv_, (const float*)(ws + WS_SB) + (size_t)(h * 64 + c) * 4096, s);
            const ScanSrc S = rwkv_src(ws, L, h);
            f2 ka2[4]; { const float* kp = p.in[19] + L * 1024 + h * 64 + (lane_id_v() & 7) * 8; const f4 x = *(const f4*)(kp), y = *(const f4*)(kp + 4); ka2[0] = (f2){x[0], x[1]}; ka2[1] = (f2){x[2], x[3]}; ka2[2] = (f2){y[0], y[1]}; ka2[3] = (f2){y[2], y[3]}; }
            f2 rk2[4]; { const float* rp = p.in[20] + L * 1024 + h * 64 + (lane_id_v() & 7) * 8; const f4 x = *(const f4*)(rp), y = *(const f4*)(rp + 4); rk2[0] = (f2){x[0], x[1]}; rk2[1] = (f2){x[2], x[3]}; rk2[2] = (f2){y[0], y[1]}; rk2[3] = (f2){y[2], y[3]}; }
            scan_run<true, true>(wv_, ldsw, S, c * 128, 128, s, pd, ka2, 1.f, (u16*)(ws + WS_YR) + h * 64, 1024, 1.0f, true, rk2, (float*)(ws + WS_BD) + h);
        } else {
            const int idx = tb * 4 + wave - 4; const int hh = idx >> 6, c = idx & 63, hd = hh >> 1, half = hh & 1;
            if (c > 0) state_load(wv_, (const float*)(ws + WS_SGB) + ((size_t)(hd * 64 + c) * 128 + half * 64) * 64, s);
            const ScanSrc S = gla_src(ws, hd, half); const f2 pd0[4] = {(f2){1.f, 1.f}, (f2){1.f, 1.f}, (f2){1.f, 1.f}, (f2){1.f, 1.f}};
            scan_run<false, true>(wv_, ldsw, S, c * 128, 128, s, pd, pd0, 1.f, (u16*)(ws + WS_OG) + hd * 128 + half * 64, 1024, 0.125f);
        }
    }
}
__device__ __forceinline__ f4 ld_bf16x4(const u16* p) { const u32x2 w = *(const u32x2*)p; return (f4){__builtin_bit_cast(float, w.x << 16), __builtin_bit_cast(float, w.x & 0xffff0000u), __builtin_bit_cast(float, w.y << 16), __builtin_bit_cast(float, w.y & 0xffff0000u)}; }
__device__ __forceinline__ void phase_post(const int wv_, const Params& p, int L) {
    unsigned char* ws = launder_p(p.ws); const int lane = TIDX & 63, w = TIDX >> 6;
    const u16* OG = (const u16*)(ws + WS_OG); const u16* YR = (const u16*)(ws + WS_YR); const float* zG = (const float*)(ws + WS_ZG);
    const float* R = (const float*)(ws + WS_R); const float* K = (const float*)(ws + WS_K); const float* ALR = (const float*)(ws + WS_B); const float* V = (const float*)(ws + (L == 0 ? WS_V0 : WS_V1)); const u16* G = (const u16*)(ws + WS_GATE); const float* BD = (const float*)(ws + WS_BD); const u16* GGp = (const u16*)(ws + WS_GG);
    u16* mixA = (u16*)(ws + WS_HA);
    const int xaddr = (lane ^ 16) << 2;
    for (int t = blockIdx.x * 8 + w; t < T; t += gridDim.x * 8) {
#pragma unroll
        for (int ch = 0; ch < 4; ++ch) { const int c = ch * 256 + lane * 4;
            const f4 o = ld_bf16x4(OG + (size_t)t * 1024 + c), gg = ld_bf16x4(GGp + (size_t)t * 1024 + c), nw = *(const f4*)(p.in[11] + L * 1024 + c);
            float ss = red16(o[0] * o[0] + o[1] * o[1] + o[2] * o[2] + o[3] * o[3]);
            ss += __builtin_bit_cast(float, __builtin_amdgcn_ds_bpermute(xaddr, __builtin_bit_cast(int, ss)));
            const float rs = rsqrtf(ss * (1.0f / 128.0f) + 1e-6f);
            float r[4];
#pragma unroll
            for (int q = 0; q < 4; ++q) r[q] = ((o[q] * rs) * nw[q]) * (gg[q] * sigm(gg[q]));
            u32x2 wv; wv.x = pk_bf16(r[0], r[1]); wv.y = pk_bf16(r[2], r[3]); *(u32x2*)(mixA + (size_t)t * 2048 + c) = wv; }
#pragma unroll
        for (int ch = 0; ch < 4; ++ch) { const int c = ch * 256 + lane * 4; const size_t o = (size_t)t * 1024 + c;
            const f4 y = ld_bf16x4(YR + o), v = *(const f4*)(V + o), gt = ld_bf16x4(G + o);
            const f4 gw = *(const f4*)(p.in[21] + L * 1024 + c), gb = *(const f4*)(p.in[22] + L * 1024 + c);
            const float bs = BD[(size_t)t * 16 + ch * 4 + (lane >> 4)];
            const float mean = red16((y[0] + y[1]) + (y[2] + y[3])) * (1.0f / 64.0f); const f4 d = y - mean;
            const float var = red16(d[0] * d[0] + d[1] * d[1] + d[2] * d[2] + d[3] * d[3]) * (1.0f / 64.0f); const float rs = rsqrtf(var + 64e-5f);
            const f4 out = ((d * rs) * gw + gb + bs * v) * gt;
            u32x2 wv; wv.x = pk_bf16(out[0], out[1]); wv.y = pk_bf16(out[2], out[3]); *(u32x2*)(mixA + (size_t)t * 2048 + 1024 + c) = wv; }
    }
}
template <class Epi> __device__ __forceinline__ void run_gemm(const int wv_, unsigned char* lds, const u16* A, const u16* Bt, int M, int N, int K, const Epi& E) {
    M = launder_s(M); N = launder_s(N); K = launder_s(K);
    pg8::Gemm g{A, Bt, M, N, K, A, 1 << 30, 1 << 30}; pg8::StaticOrder S; S.init(M, N, (int)gridDim.x, (int)blockIdx.x);
    pg8::gemm_phase<Epi, pg8::StaticOrder, false>(wv_, (PG8_LAS unsigned char*)lds, g, S, E, nullptr);
}
#define WSP() unsigned char* ws = launder_p(p.ws); const float* mod = (const float*)(ws + WS_MOD); u16* hA = (u16*)(ws + WS_HA); u16* Y = (u16*)(ws + WS_Y); (void)mod; (void)hA; (void)Y
#ifndef DUP_MASK
#define DUP_MASK 0
#endif
#define REP(bit) for (int rep_ = 0, nrep_ = 1 + ((launder_s(DUP_MASK) >> (bit)) & 1); rep_ < nrep_; ++rep_)
#define BAR() xcd_barrier(wv_, xb)
__global__ void __launch_bounds__(512) mega(Params p) {
    extern __shared__ __attribute__((aligned(16))) unsigned char lds[];
    cg::grid_group grid = cg::this_grid();
    float* ldsf = (float*)lds;
    const int wv_ = __builtin_amdgcn_readfirstlane((int)threadIdx.x >> 6);
    if (p.ws == nullptr) grid.sync();
    volatile LAS unsigned* xst = (volatile LAS unsigned*)((LAS unsigned char*)lds + 147456);
    if (TIDX < 4) xst[TIDX] = 0u;
    __syncthreads();
    const XcdBarrier xb = xcd_barrier_post(wv_, (unsigned*)(p.ws + WS_CTL), xst);
    phase_ada(wv_, p, ldsf); phase_conv(wv_, p, 0, ldsf);
    BAR();
    REP(10) { phase_ada(wv_, p, ldsf); phase_conv(wv_, p, 0, ldsf); BAR(); }
    REP(12) { WSP(); phase_rowwise(wv_, p.in[0], nullptr, nullptr, nullptr, nullptr, p.in[4], mod + 2048, mod, hA); BAR(); }
#pragma unroll 1
    for (int L0 = 0; L0 < 2; ++L0) {
        REP(0) { WSP(); EpiZ E{(float*)(ws + WS_ZG), (u16*)(ws + WS_ZR), (u16*)(ws + WS_GG)}; run_gemm(wv_, lds, hA, (const u16*)(ws + WS_WIN), T, NINP, 2048, E); BAR(); }
        REP(1) { phase_prep(wv_, p, launder_s(L0)); BAR(); }
        { WSP(); const int L = launder_s(L0);
          EpiGen4 E{(float*)(ws + WS_W), (float*)(ws + WS_B), (float*)(ws + WS_GATE), (float*)(ws + WS_V1), p.in[13] + L * 1024, p.in[15] + L * 1024, p.in[26], (const float*)(ws + WS_V0)};
          const int M_ = launder_s(T), N_ = launder_s(L == 0 ? 3072 : 4096), K_ = launder_s(256);
          pg8::Gemm g{(const u16*)(ws + WS_ACAT1), (const u16*)(ws + WS_LRT), M_, N_, K_, (const u16*)(ws + WS_ACAT2), 8, 12}; pg8::StaticOrder S; S.init(M_, N_, (int)gridDim.x, (int)blockIdx.x);
          pg8::gemm_phase<EpiGen4, pg8::StaticOrder, false>(wv_, (PG8_LAS unsigned char*)lds, g, S, E, nullptr); }
        BAR();
        REP(3) { phase_scan1(wv_, p, launder_s(L0), ldsf); BAR(); }
        REP(4) { phase_scan2(wv_, p, ldsf); BAR(); }
        REP(5) { phase_scan3(wv_, p, launder_s(L0), ldsf); BAR(); }
        REP(6) { phase_post(wv_, p, launder_s(L0)); BAR(); }
        REP(7) { WSP(); EpiBf16 E{Y, 2048}; run_gemm(wv_, lds, hA, (const u16*)(ws + WS_WOUT), T, 2048, 2048, E); BAR(); }
        { WSP(); const int L = launder_s(L0); const float* modL = mod + L * 12288;
          phase_rowwise(wv_, L == 0 ? p.in[0] : p.out, Y, modL + 4096, p.in[5] + L * 2048, p.out, p.in[6] + L * 2048, modL + 8192, modL + 6144, hA); }
        BAR();
        REP(8) { WSP(); EpiRelu2 E{(u16*)(ws + WS_U), 8192}; run_gemm(wv_, lds, hA, (const u16*)(ws + WS_WFF1), T, 8192, 2048, E); BAR(); }
        REP(9) { WSP(); EpiBf16 E{Y, 2048}; run_gemm(wv_, lds, (const u16*)(ws + WS_U), (const u16*)(ws + WS_WFF2), T, 2048, 8192, E); BAR(); }
        if (L0 == 0) {
            { WSP(); phase_rowwise(wv_, p.out, Y, mod + 10240, p.in[7], p.out, p.in[4] + 2048, mod + 12288 + 2048, mod + 12288, hA); }
            phase_conv(wv_, p, 1, ldsf);
            BAR();
        } else {
            { WSP(); phase_rowwise(wv_, p.out, Y, mod + 12288 + 10240, p.in[7] + 2048, p.out, nullptr, nullptr, nullptr, nullptr); }
        }
    }
}
extern "C" void kernel_launch(void* const* d_in, const int* in_sizes, int n_in, void* d_out, int out_size, void* d_ws, size_t ws_size, hipStream_t stream) {
    static int grid_blocks = 0;
    constexpr size_t kLds = 147456 + 64;
    if (!grid_blocks) {
        int dev = 0, cus = 0, per_cu = 0;
        (void)hipGetDevice(&dev);
        (void)hipDeviceGetAttribute(&cus, hipDeviceAttributeMultiprocessorCount, dev);
        (void)hipFuncSetAttribute((const void*)mega, hipFuncAttributeMaxDynamicSharedMemorySize, (int)kLds);
        (void)hipOccupancyMaxActiveBlocksPerMultiprocessor(&per_cu, (const void*)mega, 512, kLds);
        if (ws_size < WS_END || n_in != 30) { fprintf(stderr, "kernel_launch: workspace %zu < %zu or n_in %d != 30\n", ws_size, (size_t)WS_END, n_in); grid_blocks = -1; return; }
        if (per_cu < 1) fprintf(stderr, "kernel_launch: occupancy query says %d blocks/CU\n", per_cu);
        if (cus < 256) { fprintf(stderr, "kernel_launch: needs >= 256 CUs, device has %d\n", cus); grid_blocks = -1; return; }
        grid_blocks = cus;
    }
    if (grid_blocks < 0) return;
    (void)hipMemsetAsync((unsigned char*)d_ws + WS_CTL, 0, 16384, stream);
    Params p{};
    for (int i = 0; i < 30; ++i) p.in[i] = (const float*)d_in[i];
    p.out = (float*)d_out; p.ws = (unsigned char*)d_ws;
    void* args[] = {&p};
    hipError_t e = hipLaunchCooperativeKernel((void*)mega, dim3(grid_blocks), dim3(512), args, kLds, stream);
    if (e != hipSuccess) fprintf(stderr, "cooperative launch failed: %s (grid %d)\n", hipGetErrorString(e), grid_blocks);
}
```

```cpp
#define DUP_MASK 0
#include <hip/hip_runtime.h>
#include <hip/hip_cooperative_groups.h>
#include <cstdio>
namespace cg = cooperative_groups;
__device__ __forceinline__ int launder_v(int x) { asm volatile("" : "+v"(x)); return x; }
__device__ __forceinline__ int launder_s(int x) { asm volatile("" : "+s"(x)); return x; }
__device__ __forceinline__ int lane_id_v() { int x; asm volatile("v_mbcnt_lo_u32_b32 %0, -1, 0\n\tv_mbcnt_hi_u32_b32 %0, -1, %0" : "=v"(x)); return x; }
#define TIDX (launder_s(wv_) * 64 + lane_id_v())
__device__ __forceinline__ unsigned char* launder_p(unsigned char* x) { unsigned long long v = (unsigned long long)x; asm volatile("" : "+s"(v)); return (unsigned char*)(__attribute__((address_space(1))) unsigned char*)v; }
namespace pg8 {
#define PG8_LAS __attribute__((address_space(3)))
typedef unsigned short bf16_t;
typedef short bf16x8 __attribute__((ext_vector_type(8)));
typedef float f32x4 __attribute__((ext_vector_type(4)));
typedef unsigned u32x4 __attribute__((ext_vector_type(4)));
constexpr int BM = 256, BK = 64, HALF = 128, HTB = HALF * BK * 2  , STAGE_BYTES = 8 * HTB, NXCD = 8, WGM = 8;

__host__ __device__ __forceinline__ int lds_byte(int r, int c) { const int st = (r >> 4) * 2 + (c >> 5), rr = r & 15, cc = c & 31, ob = rr * 64 + cc * 2; return st * 1024 + (ob ^ (((ob >> 9) & 1) << 5)); }
__host__ __device__ __forceinline__ void stage_rc(int b, int& R, int& C) { const int st = b / 1024, sb = b % 1024, swz = sb ^ (((sb >> 9) & 1) << 5); R = (st >> 1) * 16 + swz / 64; C = (st & 1) * 32 + (swz % 64) / 2; }
__host__ __device__ __forceinline__ int perm32(int rho) { const int n = rho >> 4, i = rho & 15; return 8 * (i >> 2) + 4 * n + (i & 3); }

struct Unit { int pm, pn; };
struct Gemm { const bf16_t* A; const bf16_t* Bt; int M, N, K; const bf16_t* A2; int a2_lo, a2_hi; };

struct StaticOrder {
    int nM, nN, nwg, G, c;
    __host__ __device__ void init(int M, int N, int G_, int c_) { nM = M / BM; nN = N / BM; nwg = nM * nN; G = G_; c = c_; }
    __host__ __device__ bool next(int i, Unit& u) const {
        const long L = (long)i * G + c; if (L >= nwg) return false;
        int wgid = (int)L; { const int q = nwg / NXCD, r = nwg % NXCD, xcd = wgid % NXCD, off = wgid / NXCD; wgid = (xcd < r ? xcd * (q + 1) : r * (q + 1) + (xcd - r) * q) + off; }
        const int nig = WGM * nN, gid = wgid / nig, fm = gid * WGM, gsz = (nM - fm) < WGM ? (nM - fm) : WGM;
        u.pm = fm + ((wgid % nig) % gsz); u.pn = (wgid % nig) / gsz; return true;
    }
    __device__ __forceinline__ void a_ready(const Unit&) const {}
    __device__ __forceinline__ void done(const Unit&) const {}
};
__device__ __forceinline__ unsigned cvt_pk_bf16(float lo, float hi) { unsigned r; asm volatile("v_cvt_pk_bf16_f32 %0, %1, %2" : "=v"(r) : "v"(lo), "v"(hi)); return r; }
template <class Epi, class Sched, bool STAMP = false>
__device__ __forceinline__ void gemm_phase(const int wv_, PG8_LAS unsigned char* lds, const Gemm g, const Sched& S, const Epi& E, unsigned long long* stamps) {
    const int tid = TIDX, wid = __builtin_amdgcn_readfirstlane(tid >> 6), lane = tid & 63, wr = wid >> 2, wc = wid & 3, fr = lane & 15, fq = lane >> 4;
    const int K = g.K, nt = K / BK;
    int ts_lo = 0, ts_hi = 0, nts = 0; const unsigned long long rt_entry = STAMP ? (unsigned long long)wall_clock64() : 0ull;
#define PG8_STAMP() do { if (STAMP && wid == 0 && nts < 64) { const unsigned long long _c = (unsigned long long)clock64(); \
        ts_lo = (lane == nts) ? (int)(unsigned)_c : ts_lo; ts_hi = (lane == nts) ? (int)(unsigned)(_c >> 32) : ts_hi; ++nts; } } while (0)
    PG8_STAMP();
    unsigned voffA[2], voffB[2];
#pragma unroll
    for (int i = 0; i < 2; ++i) { int R, C; stage_rc(tid * 16 + i * 8192, R, C); const int Rb = Epi::PERM ? ((R & ~31) + perm32(R & 31)) : R;
        voffA[i] = (unsigned)(R * K + C) * 2u; voffB[i] = (unsigned)(Rb * K + C) * 2u; }
    const size_t kstep = (size_t)(BK * 2);
    const size_t hstep = (size_t)HALF * K * 2;
    const size_t tstep = 2 * hstep;
    const unsigned ldsw = (unsigned)wid * 1024u;
    const int aoff = lds_byte(wr * 64 + fr, fq * 8), boff = lds_byte(wc * 32 + fr, fq * 8);
#define PG8_SA(b, h) (((b) * 2 + (h)) * HTB)
#define PG8_SB(b, h) ((4 + (b) * 2 + (h)) * HTB)
#define PG8_STAGE(bufoff, gbase, voff) do { _Pragma("unroll") for (int _i = 0; _i < 2; ++_i) \
        __builtin_amdgcn_global_load_lds((const unsigned*)((const char*)(gbase) + (voff)[_i]), (PG8_LAS unsigned*)(lds + (bufoff) + ldsw + _i * 8192), 16, 0, 0); } while (0)
#define PG8_LDA(dst, b, h) do { _Pragma("unroll") for (int m = 0; m < 4; ++m) _Pragma("unroll") for (int k = 0; k < 2; ++k) dst[m][k] = *(const PG8_LAS bf16x8*)(lds + PG8_SA(b, h) + aoff + m * 2048 + k * 1024); } while (0)
#define PG8_LDB(dst, b, h) do { _Pragma("unroll") for (int n = 0; n < 2; ++n) _Pragma("unroll") for (int k = 0; k < 2; ++k) dst[n][k] = *(const PG8_LAS bf16x8*)(lds + PG8_SB(b, h) + boff + n * 2048 + k * 1024); } while (0)
#define PG8_MMA(ai, bj, At, Bt) do { __builtin_amdgcn_s_setprio(1); _Pragma("unroll") for (int m = 0; m < 4; ++m) _Pragma("unroll") for (int n = 0; n < 2; ++n) _Pragma("unroll") for (int k = 0; k < 2; ++k) \
        acc[ai][bj][m][n] = __builtin_amdgcn_mfma_f32_16x16x32_bf16(Bt[n][k], At[m][k], acc[ai][bj][m][n], 0, 0, 0); __builtin_amdgcn_s_setprio(0); } while (0)
#define PG8_WAIT_V(n) asm volatile("s_waitcnt vmcnt(" #n ")" ::: "memory")
#define PG8_WAIT_L(n) asm volatile("s_waitcnt lgkmcnt(" #n ")" ::: "memory")
#define PG8_BAR __builtin_amdgcn_s_barrier()
#define PG8_SCHED __builtin_amdgcn_sched_barrier(0)
    Unit cur, nxt; int ui = 0;
    if (!S.next(0, cur)) return;
    f32x4 acc[2][2][4][2];
#pragma unroll
    for (int a = 0; a < 2; ++a)
#pragma unroll
        for (int b = 0; b < 2; ++b)
#pragma unroll
            for (int m = 0; m < 4; ++m)
#pragma unroll
                for (int n = 0; n < 2; ++n) acc[a][b][m][n] = (f32x4){0.f, 0.f, 0.f, 0.f};
    bf16x8 At[4][2], B0[2][2], B1[2][2];
    const char* cA = (const char*)((cur.pn >= g.a2_lo && cur.pn < g.a2_hi) ? g.A2 : g.A) + (size_t)cur.pm * tstep; const char* cB = (const char*)g.Bt + (size_t)cur.pn * tstep;
    S.a_ready(cur);
    PG8_STAGE(PG8_SB(0, 0), cB, voffB); PG8_STAGE(PG8_SA(0, 0), cA, voffA); PG8_STAGE(PG8_SB(0, 1), cB + hstep, voffB); PG8_STAGE(PG8_SA(0, 1), cA + hstep, voffA);
    if (wr == 1) PG8_BAR;
    PG8_WAIT_V(4); PG8_BAR;
    PG8_STAGE(PG8_SB(1, 0), cB + kstep, voffB); PG8_STAGE(PG8_SA(1, 0), cA + kstep, voffA); PG8_STAGE(PG8_SB(1, 1), cB + hstep + kstep, voffB);
    PG8_WAIT_V(6); PG8_BAR;
    PG8_STAMP();
    for (;;) {
        const bool has_next = S.next(ui + 1, nxt);
        const char* nA = has_next ? (const char*)((nxt.pn >= g.a2_lo && nxt.pn < g.a2_hi) ? g.A2 : g.A) + (size_t)nxt.pm * tstep : cA; const char* nB = has_next ? (const char*)g.Bt + (size_t)nxt.pn * tstep : cB;
        for (int t = 0; t < nt; t += 2) {
            const bool last = (t == nt - 2);
            const char* a1 = cA + (size_t)(t + 1) * kstep;
            const char* a2 = last ? nA : cA + (size_t)(t + 2) * kstep; const char* b2 = last ? nB : cB + (size_t)(t + 2) * kstep;
            const char* a3 = a2 + kstep; const char* b3 = b2 + kstep;
            if (last && has_next) S.a_ready(nxt);
            PG8_LDB(B0, 0, 0); PG8_SCHED; PG8_LDA(At, 0, 0); PG8_STAGE(PG8_SA(1, 1), a1 + hstep, voffA);
            PG8_WAIT_L(8); PG8_BAR; PG8_WAIT_L(0); PG8_MMA(0, 0, At, B0); PG8_BAR; PG8_SCHED;
            PG8_LDB(B1, 0, 1); PG8_STAGE(PG8_SB(0, 0), b2, voffB);
            PG8_BAR; PG8_WAIT_L(0); PG8_MMA(0, 1, At, B1); PG8_BAR;
            PG8_LDA(At, 0, 1); PG8_STAGE(PG8_SA(0, 0), a2, voffA);
            PG8_BAR; PG8_WAIT_L(0); PG8_MMA(1, 0, At, B0); PG8_BAR; PG8_SCHED;
            PG8_STAGE(PG8_SB(0, 1), b2 + hstep, voffB);
            PG8_WAIT_V(6); PG8_BAR; PG8_MMA(1, 1, At, B1); PG8_BAR;
            PG8_LDB(B0, 1, 0); PG8_SCHED; PG8_LDA(At, 1, 0); PG8_STAGE(PG8_SA(0, 1), a2 + hstep, voffA);
            PG8_WAIT_L(8); PG8_BAR; PG8_WAIT_L(0); PG8_MMA(0, 0, At, B0); PG8_BAR; PG8_SCHED;
            PG8_LDB(B1, 1, 1); PG8_STAGE(PG8_SB(1, 0), b3, voffB);
            PG8_BAR; PG8_WAIT_L(0); PG8_MMA(0, 1, At, B1); PG8_BAR;
            PG8_LDA(At, 1, 1); PG8_STAGE(PG8_SA(1, 0), a3, voffA);
            PG8_BAR; PG8_WAIT_L(0); PG8_MMA(1, 0, At, B0); PG8_BAR; PG8_SCHED;
            PG8_STAGE(PG8_SB(1, 1), b3 + hstep, voffB);
            PG8_WAIT_V(6); PG8_BAR; PG8_MMA(1, 1, At, B1); PG8_BAR;
        }
        PG8_STAMP();
        if constexpr (!Epi::AFTER_DRAIN) { E(acc, cur, wr, wc, fr, fq); S.done(cur); }
        PG8_STAMP();
        if (!has_next) break;
#pragma unroll
        for (int a = 0; a < 2; ++a)
#pragma unroll
            for (int b = 0; b < 2; ++b)
#pragma unroll
                for (int m = 0; m < 4; ++m)
#pragma unroll
                    for (int n = 0; n < 2; ++n) acc[a][b][m][n] = (f32x4){0.f, 0.f, 0.f, 0.f};
        cur = nxt; cA = nA; cB = nB; ++ui;
    }
    PG8_WAIT_V(0);
    if (wr == 0) PG8_BAR;
    PG8_BAR;
    if constexpr (Epi::AFTER_DRAIN) { E.fused(acc, cur, wr, wc, fr, fq, lds, wid, lane); S.done(cur); }
    PG8_STAMP();
    if (STAMP && wid == 0) { stamps[lane] = lane < nts ? (((unsigned long long)(unsigned)ts_hi << 32) | (unsigned)ts_lo) : 0ull;
        if (lane == 62) stamps[62] = rt_entry; if (lane == 63) stamps[63] = (unsigned long long)wall_clock64(); }
#undef PG8_STAMP
#undef PG8_SA
#undef PG8_SB
#undef PG8_STAGE
#undef PG8_LDA
#undef PG8_LDB
#undef PG8_MMA
#undef PG8_WAIT_V
#undef PG8_WAIT_L
#undef PG8_BAR
#undef PG8_SCHED
}
}
typedef unsigned short u16;
typedef float f4 __attribute__((ext_vector_type(4)));
typedef float f2 __attribute__((ext_vector_type(2)));
typedef unsigned u32x2 __attribute__((ext_vector_type(2)));
typedef unsigned u32x4 __attribute__((ext_vector_type(4)));
using pg8::f32x4;
constexpr int T = 8192, D = 2048, DFF = 8192;
constexpr int NG = 3328, NR = 3584, NINP = 6912;
constexpr size_t MiB = 1048576;
constexpr size_t WS_WIN = 0, WS_WOUT = 27 * MiB, WS_WFF1 = 35 * MiB, WS_WFF2 = 67 * MiB, WS_LRT = 99 * MiB, WS_GUPT = 101 * MiB, WS_MOD = 102 * MiB,
                 WS_ACAT1 = 103 * MiB, WS_ACAT2 = 107 * MiB, WS_HA = 112 * MiB, WS_Y = 144 * MiB, WS_YR = 144 * MiB, WS_OG = 176 * MiB,
                 WS_ZG = 208 * MiB, WS_ZR = 312 * MiB, WS_NB = 312 * MiB, WS_MB = 328 * MiB, WS_SB = 344 * MiB, WS_NGB = 360 * MiB, WS_SGB = 376 * MiB, WS_PGB = 392 * MiB,
                 WS_U = 208 * MiB, WS_V0 = 424 * MiB, WS_W = 456 * MiB, WS_A = 488 * MiB, WS_B = 520 * MiB, WS_K = 552 * MiB, WS_R = 584 * MiB, WS_V1 = 616 * MiB,
                 WS_GATE = 648 * MiB, WS_ALPHA = 680 * MiB, WS_CTL = 696 * MiB, WS_BD = 393 * MiB  , WS_GG = 394 * MiB  , WS_END = 697 * MiB;

struct Params { const float* in[30]; float* out; unsigned char* ws; };

__device__ __forceinline__ unsigned pk_bf16(float lo, float hi) { return pg8::cvt_pk_bf16(lo, hi); }
__device__ __forceinline__ u16 to_bf16(float v) { return (u16)(pk_bf16(v, 0.f) & 0xffffu); }
__device__ __forceinline__ float sigm(float x) { return 1.0f / (1.0f + __expf(-x)); }
template <int CTRL> __device__ __forceinline__ float dppf(float x) { return __builtin_bit_cast(float, __builtin_amdgcn_mov_dpp(__builtin_bit_cast(int, x), CTRL, 0xf, 0xf, true)); }
__device__ __forceinline__ float red8(float x) { x += dppf<0xB1>(x); x += dppf<0x4E>(x); x += dppf<0x141>(x); return x; }

__device__ __forceinline__ float red16(float x) { x = red8(x); x += dppf<0x140>(x); return x; }
__device__ __forceinline__ float rl(float x, int l) { return __builtin_bit_cast(float, __builtin_amdgcn_readlane(__builtin_bit_cast(int, x), l)); }
__device__ __forceinline__ float wave_sum(float v) { const float r = red16(v); return (rl(r, 0) + rl(r, 16)) + (rl(r, 32) + rl(r, 48)); }
__device__ __forceinline__ float half_sum(float v) { const float r = red16(v); const float lo = rl(r, 0) + rl(r, 16), hi = rl(r, 32) + rl(r, 48); return (lane_id_v() & 32) ? hi : lo; }
#define XB_TMO      128
#define XB_XCNT(j)  (256  + 64 * (j))
#define XB_XSUB(j)  (1280 + 64 * (j))
#define XB_XGEN(j)  (2304 + 64 * (j))
#define XB_TOP      3328
#define XB_TOPGEN   3392
#define XCD_BAR_WORDS 3456
#define XB_SPIN_CAP (1u << 22)
#define LAS __attribute__((address_space(3)))
__device__ __forceinline__ unsigned xb_ld(unsigned* p)              { return __hip_atomic_load(p, __ATOMIC_RELAXED, __HIP_MEMORY_SCOPE_AGENT); }
__device__ __forceinline__ unsigned xb_add(unsigned* p, unsigned v) { return __hip_atomic_fetch_add(p, v, __ATOMIC_RELAXED, __HIP_MEMORY_SCOPE_AGENT); }
__device__ __forceinline__ unsigned xb_xcc_id() { return (unsigned)__builtin_amdgcn_s_getreg((3 << 11) | 20) & 0xFu; }
#define XB_SPIN(cond, bar) do { unsigned _sp = 0; while (cond) { __builtin_amdgcn_s_sleep(1); \
    if ((++_sp & 255u) == 0u) { if (xb_ld(&(bar)[XB_TMO])) break; if (_sp > XB_SPIN_CAP) { atomicAdd(&(bar)[XB_TMO], 1u); break; } } } } while (0)
struct XcdBarrier { unsigned* bar; unsigned x; volatile LAS unsigned* st; };
__device__ __forceinline__ XcdBarrier xcd_barrier_post(const int wv_, unsigned* bar, volatile LAS unsigned* st) {
    XcdBarrier b; b.bar = bar; b.x = xb_xcc_id(); b.st = st;
    if (TIDX == 0) (void)xb_add(&bar[XB_XCNT(b.x)], 1u);
    return b;
}
__device__ __forceinline__ void xcd_barrier_complete(unsigned* bar, unsigned x, unsigned& nloc, unsigned& nx) {
    const unsigned G = gridDim.x * gridDim.y * gridDim.z;
    unsigned sum, cnt, mine, sp = 0u;
    for (;;) {
        sum = 0u; cnt = 0u; mine = 0u;
#pragma unroll
        for (unsigned j = 0; j < 16; ++j) { const unsigned c = xb_ld(&bar[XB_XCNT(j)]); sum += c; cnt += (c > 0u) ? 1u : 0u; mine = (j == x) ? c : mine; }
        if (sum == G) break;
        __builtin_amdgcn_s_sleep(1);
        if ((++sp & 255u) == 0u) { if (xb_ld(&bar[XB_TMO])) break; if (sp > XB_SPIN_CAP) { atomicAdd(&bar[XB_TMO], 1u); break; } }
    }
    nloc = mine > 0u ? mine : 1u; nx = cnt > 0u ? cnt : 1u;
}
__device__ __forceinline__ void xcd_barrier(const int wv_, const XcdBarrier& b) {
    asm volatile("s_waitcnt vmcnt(0)" ::: "memory");
    __syncthreads();
    unsigned* bar = (unsigned*)launder_p((unsigned char*)b.bar); const unsigned bx = (unsigned)launder_s((int)b.x);
    if (TIDX == 0) {
        __builtin_amdgcn_s_waitcnt(0);
        unsigned nloc = b.st[0], nx = b.st[1];
        if (nloc == 0u) { xcd_barrier_complete(bar, bx, nloc, nx); b.st[0] = nloc; b.st[1] = nx; }
        const unsigned old = xb_add(&bar[XB_XSUB(bx)], 1u);
        const unsigned gen = old / nloc;
        if (old + 1u == (gen + 1u) * nloc) {
            __builtin_amdgcn_fence(__ATOMIC_RELEASE, "agent");
            asm volatile("s_waitcnt vmcnt(0)" ::: "memory");
            const unsigned og = xb_add(&bar[XB_TOP], 1u);
            const unsigned tg = og / nx;
            if (og + 1u == (tg + 1u) * nx) xb_add(&bar[XB_TOPGEN], 1u);
            else XB_SPIN(xb_ld(&bar[XB_TOPGEN]) == tg, bar);
            __builtin_amdgcn_fence(__ATOMIC_ACQUIRE, "agent");
            xb_add(&bar[XB_XGEN(bx)], 1u);
            asm volatile("s_waitcnt vmcnt(0)" ::: "memory");
        } else {
            XB_SPIN(xb_ld(&bar[XB_XGEN(bx)]) == gen, bar);
            __builtin_amdgcn_fence(__ATOMIC_ACQUIRE, "agent");
            asm volatile("s_waitcnt vmcnt(0)" ::: "memory");
        }
    }
    __syncthreads();
}
struct ConvJob { const float* src; int src_ld; u16* dst; int dst_ld; int nrows, nk; };
constexpr int NJOBS = 15;
__device__ __forceinline__ ConvJob conv_job(const Params& p, int L, int j) {
    unsigned char* ws = launder_p(p.ws);
    u16* WinT = (u16*)(ws + WS_WIN); u16* WoutT = (u16*)(ws + WS_WOUT); u16* Wff1T = (u16*)(ws + WS_WFF1); u16* Wff2T = (u16*)(ws + WS_WFF2);
    u16* LrT = (u16*)(ws + WS_LRT); u16* GupT = (u16*)(ws + WS_GUPT);
    ConvJob J; J.src = nullptr; J.src_ld = 0; J.dst = WinT; J.dst_ld = 2048; J.nrows = 0; J.nk = 0;
    if (j == 0)       { J.src = p.in[8] + (size_t)L * 2048 * 6608;        J.src_ld = 6608; J.dst = WinT;                       J.dst_ld = 2048; J.nrows = 3088; J.nk = 2048; }
    else if (j == 1)  {                                                                    J.dst = WinT + (size_t)3088 * 2048; J.dst_ld = 2048; J.nrows = 240;  J.nk = 2048; }
    else if (j == 2)  { J.src = p.in[8] + (size_t)L * 2048 * 6608 + 3088; J.src_ld = 6608; J.dst = WinT + (size_t)3328 * 2048; J.dst_ld = 2048; J.nrows = 3520; J.nk = 2048; }
    else if (j == 3)  { J.src = (L == 1) ? p.in[23] : nullptr;            J.src_ld = 64;   J.dst = WinT + (size_t)6848 * 2048; J.dst_ld = 2048; J.nrows = 64;   J.nk = 2048; }
    else if (j == 4)  { J.src = p.in[27] + (size_t)L * 2048 * 2048;       J.src_ld = 2048; J.dst = WoutT;                      J.dst_ld = 2048; J.nrows = 2048; J.nk = 2048; }
    else if (j == 5)  { J.src = p.in[28] + (size_t)L * 2048 * 8192;       J.src_ld = 8192; J.dst = Wff1T;                      J.dst_ld = 2048; J.nrows = 8192; J.nk = 2048; }
    else if (j == 6)  { J.src = p.in[29] + (size_t)L * 8192 * 2048;       J.src_ld = 2048; J.dst = Wff2T;                      J.dst_ld = 8192; J.nrows = 2048; J.nk = 8192; }
    else if (j == 7)  { J.src = p.in[14] + (size_t)L * 96 * 1024;         J.src_ld = 1024; J.dst = LrT;                        J.dst_ld = 256;  J.nrows = 1024; J.nk = 96; }
    else if (j == 8)  {                                                                    J.dst = LrT + 96;                   J.dst_ld = 256;  J.nrows = 1024; J.nk = 160; }
    else if (j == 9)  {                                                                    J.dst = LrT + 1024 * 256;           J.dst_ld = 256;  J.nrows = 1024; J.nk = 96; }
    else if (j == 10) { J.src = p.in[16] + (size_t)L * 96 * 1024;         J.src_ld = 1024; J.dst = LrT + 1024 * 256 + 96;      J.dst_ld = 256;  J.nrows = 1024; J.nk = 96; }
    else if (j == 11) {                                                                    J.dst = LrT + 1024 * 256 + 192;     J.dst_ld = 256;  J.nrows = 1024; J.nk = 64; }
    else if (j == 12) {                                                                    J.dst = LrT + 3072 * 256;           J.dst_ld = 256;  J.nrows = 1024; J.nk = 192; }
    else if (j == 13) { J.src = (L == 1) ? p.in[25] : nullptr;            J.src_ld = 1024; J.dst = LrT + 3072 * 256 + 192;     J.dst_ld = 256;  J.nrows = 1024; J.nk = 64; }
    else              { J.src = p.in[17] + (size_t)L * 256 * 1024;        J.src_ld = 1024; J.dst = LrT + 2048 * 256;           J.dst_ld = 256;  J.nrows = 1024; J.nk = 256; }
    return J;
}
struct ConvTile { ConvJob J; int n0, k0; };
__device__ __forceinline__ ConvTile conv_tile(const Params& p, int L, int g) {
    int rem = g, jj = 0; ConvTile t; t.J = conv_job(p, L, 0);
    for (;;) { const int cnt = ((t.J.nrows + 255) >> 8) * ((t.J.nk + 63) >> 6); if (rem < cnt) break; rem -= cnt; ++jj; t.J = conv_job(p, L, jj); }
    const int ntn = (t.J.nrows + 255) >> 8; t.n0 = (rem % ntn) * 256; t.k0 = (rem / ntn) * 64; return t;
}
#define CONV_LOAD(tt, vv) do { const bool okn_ = ((tt).J.src != nullptr) && ((tt).n0 + lane * 4) < (tt).J.nrows; \
        _Pragma("unroll") for (int kk = 0; kk < 8; ++kk) { const int k_ = wave * 8 + kk; vv[kk] = (f4){0.f, 0.f, 0.f, 0.f}; \
            if (okn_ && ((tt).k0 + k_) < (tt).J.nk) vv[kk] = __builtin_nontemporal_load((const f4*)((tt).J.src + (size_t)((tt).k0 + k_) * (tt).J.src_ld + (tt).n0 + lane * 4)); } } while (0)
__device__ __forceinline__ void phase_conv(const int wv_, const Params& p, int L, float* tile) {
    const int tid = TIDX, lane = tid & 63, wave = tid >> 6;
    int total = 0;
    for (int j = 0; j < NJOBS; ++j) { const ConvJob J = conv_job(p, L, j); total += ((J.nrows + 255) >> 8) * ((J.nk + 63) >> 6); }
    int g = blockIdx.x;
    if (g >= total) return;
    ConvTile cur = conv_tile(p, L, g);
    f4 v[8];
    CONV_LOAD(cur, v);
    for (; g < total; g += gridDim.x) {
#pragma unroll
        for (int kk = 0; kk < 8; ++kk) *(f4*)(tile + (wave * 8 + kk) * 260 + lane * 4) = v[kk];
        const int gn = g + gridDim.x; ConvTile nxt = cur;
        if (gn < total) { nxt = conv_tile(p, L, gn); CONV_LOAD(nxt, v); }
        __syncthreads();
        { const int nr = tid >> 1, kh = (tid & 1) * 32;
          if ((cur.n0 + nr) < cur.J.nrows) {
#pragma unroll
              for (int c4 = 0; c4 < 4; ++c4) { const int kc = kh + c4 * 8;
                  if ((cur.k0 + kc) < cur.J.nk) { u32x4 w; const float* s = tile + kc * 260 + nr;
                      w.x = pk_bf16(s[0 * 260], s[1 * 260]); w.y = pk_bf16(s[2 * 260], s[3 * 260]); w.z = pk_bf16(s[4 * 260], s[5 * 260]); w.w = pk_bf16(s[6 * 260], s[7 * 260]);
                      *(u32x4*)(cur.J.dst + (size_t)(cur.n0 + nr) * cur.J.dst_ld + cur.k0 + kc) = w; } } } }
        __syncthreads();
        cur = nxt;
    }
}
__device__ __forceinline__ void phase_ada(const int wv_, const Params& p, float* ldsf) {
    const float* c = p.in[1]; float* mod = (float*)(p.ws + WS_MOD);
    const int tid = TIDX, c4 = tid & 31, kg = tid >> 5;
    for (int task = blockIdx.x; task < 192; task += gridDim.x) {
        const int L = task / 96, cb = task % 96;
        const float* W = p.in[2] + (size_t)L * 2048 * 12288 + cb * 128 + c4 * 4;
        f4 acc = (f4){0.f, 0.f, 0.f, 0.f};
#pragma unroll 8
        for (int k = kg; k < 2048; k += 16) { const float cv = c[k]; const float s = cv / (1.0f + __expf(-cv)); const f4 w = __builtin_nontemporal_load((const f4*)(W + (size_t)k * 12288)); acc += s * w; }
        *(f4*)(ldsf + kg * 128 + c4 * 4) = acc;
        __syncthreads();
        if (tid < 128) { float s = 0.f; for (int g2 = 0; g2 < 16; ++g2) s += ldsf[g2 * 128 + tid]; mod[L * 12288 + cb * 128 + tid] = s + p.in[3][L * 12288 + cb * 128 + tid]; }
        __syncthreads();
    }
}
__device__ __forceinline__ void phase_rowwise(const int wv_, const float* xin, const u16* y, const float* gt, const float* gpost, float* xout,
                                              const float* gpre, const float* sc, const float* sh, u16* hout) {
    const int lane = TIDX & 63, wave = TIDX >> 6;
    const int row0 = blockIdx.x * 8 + wave, rstride = gridDim.x * 8;
    f4 xn[8]; u32x2 yn[8];
#pragma unroll
    for (int i = 0; i < 8; ++i) { xn[i] = (f4){0.f, 0.f, 0.f, 0.f}; yn[i] = (u32x2){0u, 0u}; }
    if (row0 < T) {
#pragma unroll
        for (int i = 0; i < 8; ++i) { xn[i] = *(const f4*)(xin + (size_t)row0 * D + i * 256 + lane * 4); if (y != nullptr) yn[i] = *(const u32x2*)(y + (size_t)row0 * D + i * 256 + lane * 4); }
    }
    for (int row = row0; row < T; row += rstride) {
        f4 xv[8], yv[8];
#pragma unroll
        for (int i = 0; i < 8; ++i) { xv[i] = xn[i]; yv[i] = (f4){__builtin_bit_cast(float, yn[i].x << 16), __builtin_bit_cast(float, yn[i].x & 0xffff0000u), __builtin_bit_cast(float, yn[i].y << 16), __builtin_bit_cast(float, yn[i].y & 0xffff0000u)}; }
        const int nrow = row + rstride;
        if (nrow < T) {
#pragma unroll
            for (int i = 0; i < 8; ++i) { xn[i] = *(const f4*)(xin + (size_t)nrow * D + i * 256 + lane * 4); if (y != nullptr) yn[i] = *(const u32x2*)(y + (size_t)nrow * D + i * 256 + lane * 4); }
        }
        asm volatile("" ::: "memory");
        if (y != nullptr) {
            float ss = 0.f;
#pragma unroll
            for (int i = 0; i < 8; ++i) ss += yv[i][0] * yv[i][0] + yv[i][1] * yv[i][1] + yv[i][2] * yv[i][2] + yv[i][3] * yv[i][3];
            ss = wave_sum(ss); const float rs = rsqrtf(ss * (1.0f / 2048.0f) + 1e-6f);
#pragma unroll
            for (int i = 0; i < 8; ++i) { const f4 g = *(const f4*)(gpost + i * 256 + lane * 4), tt = *(const f4*)(gt + i * 256 + lane * 4); xv[i] += tt * ((yv[i] * rs) * g); }
        }
        if (xout != nullptr) {
#pragma unroll
            for (int i = 0; i < 8; ++i) *(f4*)(xout + (size_t)row * D + i * 256 + lane * 4) = xv[i];
        }
        if (hout != nullptr) {
            float ss = 0.f;
#pragma unroll
            for (int i = 0; i < 8; ++i) ss += xv[i][0] * xv[i][0] + xv[i][1] * xv[i][1] + xv[i][2] * xv[i][2] + xv[i][3] * xv[i][3];
            ss = wave_sum(ss); const float rs = rsqrtf(ss * (1.0f / 2048.0f) + 1e-6f);
#pragma unroll
            for (int i = 0; i < 8; ++i) { const f4 g = *(const f4*)(gpre + i * 256 + lane * 4), s1 = *(const f4*)(sc + i * 256 + lane * 4), s0 = *(const f4*)(sh + i * 256 + lane * 4);
                const f4 h = ((xv[i] * rs) * g) * (1.0f + s1) + s0; u32x2 w; w.x = pk_bf16(h[0], h[1]); w.y = pk_bf16(h[2], h[3]);
                *(u32x2*)(hout + (size_t)row * D + i * 256 + lane * 4) = w; }
        }
    }
}
struct EpiZ { static constexpr bool PERM = false, AFTER_DRAIN = false; float* zG; u16* zR; u16* GG;
    __device__ __forceinline__ void operator()(const f32x4 (&acc)[2][2][4][2], const pg8::Unit& u, int wr, int wc, int fr, int fq) const {
        const int row0 = u.pm * 256 + wr * 64 + fr;
        if (u.pn < 8 || u.pn == 12) { const int col0 = u.pn * 256 + wc * 32 + 4 * fq;
#pragma unroll
            for (int ai = 0; ai < 2; ++ai)
#pragma unroll
                for (int m = 0; m < 4; ++m) { float* rowp = zG + (size_t)(row0 + ai * 128 + m * 16) * NG + col0;
#pragma unroll
                    for (int bj = 0; bj < 2; ++bj)
#pragma unroll
                        for (int n = 0; n < 2; ++n) *(f32x4*)(rowp + bj * 128 + n * 16) = acc[ai][bj][m][n]; }
        } else { const bool isg = u.pn < 13;
            const int col0 = (isg ? (u.pn - 8) : (u.pn - 13)) * 256 + wc * 32 + 4 * fq; u16* const dbase = isg ? GG : zR; const int dld = isg ? 1024 : NR;
#pragma unroll
            for (int ai = 0; ai < 2; ++ai)
#pragma unroll
                for (int m = 0; m < 4; ++m) { u16* rowp = dbase + (size_t)(row0 + ai * 128 + m * 16) * dld + col0;
#pragma unroll
                    for (int bj = 0; bj < 2; ++bj)
#pragma unroll
                        for (int n = 0; n < 2; ++n) { const f32x4 v = acc[ai][bj][m][n]; u32x2 w; w.x = pk_bf16(v[0], v[1]); w.y = pk_bf16(v[2], v[3]); *(u32x2*)(rowp + bj * 128 + n * 16) = w; } }
        }
    } };
struct EpiPlain { static constexpr bool PERM = false, AFTER_DRAIN = false; float* C; int ldc;
    __device__ __forceinline__ void operator()(const f32x4 (&acc)[2][2][4][2], const pg8::Unit& u, int wr, int wc, int fr, int fq) const {
        const int row0 = u.pm * 256 + wr * 64 + fr, col0 = u.pn * 256 + wc * 32 + 4 * fq;
#pragma unroll
        for (int ai = 0; ai < 2; ++ai)
#pragma unroll
            for (int m = 0; m < 4; ++m) { float* rowp = C + (size_t)(row0 + ai * 128 + m * 16) * ldc + col0;
#pragma unroll
                for (int bj = 0; bj < 2; ++bj)
#pragma unroll
                    for (int n = 0; n < 2; ++n) *(f32x4*)(rowp + bj * 128 + n * 16) = acc[ai][bj][m][n]; }
    } };
struct EpiBf16 { static constexpr bool PERM = false, AFTER_DRAIN = false; u16* O; int ldc;
    __device__ __forceinline__ void operator()(const f32x4 (&acc)[2][2][4][2], const pg8::Unit& u, int wr, int wc, int fr, int fq) const {
        const int row0 = u.pm * 256 + wr * 64 + fr, col0 = u.pn * 256 + wc * 32 + 4 * fq;
#pragma unroll
        for (int ai = 0; ai < 2; ++ai)
#pragma unroll
            for (int m = 0; m < 4; ++m) { u16* rowp = O + (size_t)(row0 + ai * 128 + m * 16) * ldc + col0;
#pragma unroll
                for (int bj = 0; bj < 2; ++bj)
#pragma unroll
                    for (int n = 0; n < 2; ++n) { const f32x4 v = acc[ai][bj][m][n]; u32x2 w; w.x = pk_bf16(v[0], v[1]); w.y = pk_bf16(v[2], v[3]); *(u32x2*)(rowp + bj * 128 + n * 16) = w; } }
    } };
struct EpiRelu2 { static constexpr bool PERM = false, AFTER_DRAIN = false; u16* O; int ldc;
    __device__ __forceinline__ void operator()(const f32x4 (&acc)[2][2][4][2], const pg8::Unit& u, int wr, int wc, int fr, int fq) const {
        const int row0 = u.pm * 256 + wr * 64 + fr, col0 = u.pn * 256 + wc * 32 + 4 * fq;
#pragma unroll
        for (int ai = 0; ai < 2; ++ai)
#pragma unroll
            for (int m = 0; m < 4; ++m) { u16* rowp = O + (size_t)(row0 + ai * 128 + m * 16) * ldc + col0;
#pragma unroll
                for (int bj = 0; bj < 2; ++bj)
#pragma unroll
                    for (int n = 0; n < 2; ++n) { f32x4 v = acc[ai][bj][m][n];
                        v[0] = fmaxf(v[0], 0.f); v[1] = fmaxf(v[1], 0.f); v[2] = fmaxf(v[2], 0.f); v[3] = fmaxf(v[3], 0.f); v = v * v;
                        u32x2 w; w.x = pk_bf16(v[0], v[1]); w.y = pk_bf16(v[2], v[3]); *(u32x2*)(rowp + bj * 128 + n * 16) = w; } }
    } };
#define EPI_LOOP_BEGIN const int row0 = u.pm * 256 + wr * 64 + fr, col0 = u.pn * 256 + wc * 32 + 4 * fq; \
        _Pragma("unroll") for (int ai = 0; ai < 2; ++ai) _Pragma("unroll") for (int m = 0; m < 4; ++m) { _Pragma("unroll") for (int bj = 0; bj < 2; ++bj) _Pragma("unroll") for (int n = 0; n < 2; ++n) { \
            const int cl = col0 + bj * 128 + n * 16; const size_t idx = (size_t)(row0 + ai * 128 + m * 16) * 1024 + cl; const f32x4 a = acc[ai][bj][m][n];
#define EPI_LOOP_END asm volatile("" ::: "memory"); } }
struct EpiGen4 { static constexpr bool PERM = false, AFTER_DRAIN = false; float* O0; float* O1; float* O2; float* O3; const float* b0p; const float* b1p; const float* b3p; const float* V0;
    __device__ __forceinline__ void operator()(const f32x4 (&acc)[2][2][4][2], const pg8::Unit& u, int wr, int wc, int fr, int fq) const {
        const int region = u.pn >> 2;
        float* O = O0; const float* bias = b0p; int mode = 2;
        if (launder_s(region) == 1) { O = O1; bias = b1p; mode = 1; }
        if (launder_s(region) == 2) { O = O2; mode = 0; }
        if (launder_s(region) == 3) { O = O3; bias = b3p; mode = 3; }
        const int row0 = u.pm * 256 + wr * 64 + fr, col0 = (u.pn & 3) * 256 + wc * 32 + 4 * fq;
#pragma unroll
        for (int ai = 0; ai < 2; ++ai)
#pragma unroll
            for (int m = 0; m < 4; ++m) {
#pragma unroll
                for (int bj = 0; bj < 2; ++bj)
#pragma unroll
                    for (int n = 0; n < 2; ++n) { const int cl = col0 + bj * 128 + n * 16; const size_t idx = (size_t)(row0 + ai * 128 + m * 16) * 1024 + cl; const f32x4 a = acc[ai][bj][m][n];
                        f32x4 o = a;
                        if (mode != 0) { const f32x4 bb = *(const f32x4*)(bias + cl);
#pragma unroll
                            for (int q = 0; q < 4; ++q) o[q] = sigm(bb[q] + a[q]);
                            if (mode == 2) {
#pragma unroll
                                for (int q = 0; q < 4; ++q) o[q] = __expf(-0.60653065971f * o[q]);
                            } else if (mode == 3) { const f32x4 vr = *(const f32x4*)(O + idx), vf = *(const f32x4*)(V0 + idx);
#pragma unroll
                                for (int q = 0; q < 4; ++q) o[q] = vr[q] + (vf[q] - vr[q]) * o[q]; } }
                        if (mode == 0) { u32x2 w; w.x = pk_bf16(o[0], o[1]); w.y = pk_bf16(o[2], o[3]); *(u32x2*)((u16*)O + idx) = w; }
                        else *(f32x4*)(O + idx) = o;
                        asm volatile("" ::: "memory"); } }
    } };
struct EpiGen { static constexpr bool PERM = false, AFTER_DRAIN = false; float* O; const float* bias; const float* V0; int mode;
    __device__ __forceinline__ void operator()(const f32x4 (&acc)[2][2][4][2], const pg8::Unit& u, int wr, int wc, int fr, int fq) const {
        EPI_LOOP_BEGIN
            f32x4 o = a;
            if (mode != 0) { const f32x4 b0 = *(const f32x4*)(bias + cl);
#pragma unroll
                for (int q = 0; q < 4; ++q) o[q] = sigm(b0[q] + a[q]);
                if (mode == 2) {
#pragma unroll
                    for (int q = 0; q < 4; ++q) o[q] = __expf(-0.60653065971f * o[q]);
                } else if (mode == 3) { const f32x4 vr = *(const f32x4*)(O + idx), vf = *(const f32x4*)(V0 + idx);
#pragma unroll
                    for (int q = 0; q < 4; ++q) o[q] = vr[q] + (vf[q] - vr[q]) * o[q]; } }
            *(f32x4*)(O + idx) = o;
        EPI_LOOP_END
    } };
__device__ __forceinline__ void phase_prep(const int wv_, const Params& p, int L) {
    const int tid = TIDX;
    unsigned char* ws = launder_p(p.ws);
    const float* zG = (const float*)(ws + WS_ZG); const u16* zR = (const u16*)(ws + WS_ZR);
    float* R = (float*)(ws + WS_R); float* K = (float*)(ws + WS_K); float* A = (float*)(ws + WS_A);
    float* Vd = (float*)(ws + (L == 0 ? WS_V0 : WS_V1)); float* ALPHA = (float*)(ws + WS_ALPHA);
    u16* Acat1 = (u16*)(ws + WS_ACAT1); u16* Acat2 = (u16*)(ws + WS_ACAT2);
    for (int tile = blockIdx.x; tile < T / 8; tile += gridDim.x) {
        const int t0 = tile * 8;
#pragma unroll
        for (int pass = 0; pass < 2; ++pass) {
            const int c4 = pass * 512 + tid;
            if (c4 < 896) {
                const int col = c4 * 4;
                f4 mu; if (col < 3520) mu = *(const f4*)(p.in[12] + L * 3520 + col); else if (L == 1) mu = *(const f4*)(p.in[24] + col - 3520); else mu = (f4){0.f, 0.f, 0.f, 0.f};
                f4 z[9]; u32x2 zb[9];
                zb[0] = (t0 > 0) ? *(const u32x2*)(zR + (size_t)(t0 - 1) * NR + col) : (u32x2){0u, 0u};
#pragma unroll
                for (int i = 0; i < 8; ++i) zb[i + 1] = *(const u32x2*)(zR + (size_t)(t0 + i) * NR + col);
#pragma unroll
                for (int i = 0; i < 9; ++i) z[i] = (f4){__builtin_bit_cast(float, zb[i].x << 16), __builtin_bit_cast(float, zb[i].x & 0xffff0000u), __builtin_bit_cast(float, zb[i].y << 16), __builtin_bit_cast(float, zb[i].y & 0xffff0000u)};
                f4 kkw = (f4){0.f, 0.f, 0.f, 0.f}; if (pass == 0 && tid >= 256) kkw = *(const f4*)(p.in[18] + L * 1024 + col - 1024);
#pragma unroll
                for (int i = 0; i < 8; ++i) {
                    const f4 zl = z[i + 1] + mu * (z[i] - z[i + 1]); const size_t t = (size_t)(t0 + i);
                    if (pass == 0) {
                        if (tid < 256) { u32x2 wr_; wr_.x = pk_bf16(zl[0], zl[1]); wr_.y = pk_bf16(zl[2], zl[3]); *(u32x2*)((u16*)R + t * 1024 + col) = wr_; }
                        else { const f4 kv = zl * kkw; const float ss = red16(kv[0] * kv[0] + kv[1] * kv[1] + kv[2] * kv[2] + kv[3] * kv[3]);
                               const float rn = rsqrtf(fmaxf(ss, 1e-24f)); *(f4*)(K + t * 1024 + col - 1024) = zl; *(f4*)(A + t * 1024 + col - 1024) = -(kv * rn); }
                    } else {
                        if (tid < 256) *(f4*)(Vd + t * 1024 + col - 2048) = zl;
                        else { float o0, o1, o2, o3; u16* dst;
                            if (tid < 280)      { o0 = tanhf(zl[0]); o1 = tanhf(zl[1]); o2 = tanhf(zl[2]); o3 = tanhf(zl[3]); dst = Acat1 + t * 256 + (col - 3072); }
                            else if (tid < 304) { o0 = zl[0]; o1 = zl[1]; o2 = zl[2]; o3 = zl[3]; dst = Acat1 + t * 256 + (col - 3072); }
                            else if (tid < 368) { o0 = sigm(zl[0]); o1 = sigm(zl[1]); o2 = sigm(zl[2]); o3 = sigm(zl[3]); dst = Acat2 + t * 256 + (col - 3264); }
                            else                { const float m1 = (L == 1) ? 1.f : 0.f; o0 = zl[0] * m1; o1 = zl[1] * m1; o2 = zl[2] * m1; o3 = zl[3] * m1; dst = Acat1 + t * 256 + 192 + (col - 3520); }
                            u32x2 w; w.x = pk_bf16(o0, o1); w.y = pk_bf16(o2, o3); *(u32x2*)dst = w; }
                    }
                }
            }
        }
    }
    { float wa[16];
#pragma unroll
      for (int r = 0; r < 16; ++r) wa[r] = p.in[9][(size_t)L * 16 * 512 + r * 512 + tid];
      const float ba = p.in[10][L * 512 + tid];
      for (int tile = blockIdx.x; tile < T / 32; tile += gridDim.x) {
#pragma unroll 4
          for (int t = tile * 32; t < tile * 32 + 32; ++t) { float acc = ba;
#pragma unroll
              for (int r = 0; r < 16; ++r) acc += zG[(size_t)t * NG + 3072 + r] * wa[r];
              const float ls = fminf(acc, 0.f) - log1pf(expf(-fabsf(acc)));
              ALPHA[(size_t)t * 512 + tid] = expf(ls * (1.0f / 16.0f)); } } }
}
struct ScanSrc { const float* b0; const float* b1; const float* b2; const float* b3; const float* b4; const float* b5; int ld0, ld1, ld2, ld3, ld4, ld5; };
template <bool RW, bool WY>
__device__ __forceinline__ void scan_run(const int wv_, float* ldsw, const ScanSrc& S, int t0, int nsteps, f2 (&s)[8][4], f2 (&pd)[4], const f2 (&ka2)[4], float vks, u16* yout, int ldy, float yscale, bool active = true, const f2* rk2 = nullptr, float* bdout = nullptr) {
    const int lane = TIDX & 63, j = lane & 7, g = lane >> 3, lrow = lane >> 4, lcol = (lane & 15) * 4;
    if (!active) return;
    f4 pre0, pre1, pre2, pre3, pre4, pre5;
#define SCAN_LOAD(tb) do { const size_t rr = (size_t)((tb) + lrow); \
        pre0 = *(const f4*)(S.b0 + rr * S.ld0 + lcol); pre3 = *(const f4*)(S.b3 + rr * S.ld3 + lcol); pre5 = *(const f4*)(S.b5 + rr * S.ld5 + lcol); \
        if (WY) { if (RW) { const u32x2 w4_ = *(const u32x2*)((const u16*)S.b4 + rr * S.ld4 + lcol); pre4 = (f4){__builtin_bit_cast(float, w4_.x << 16), __builtin_bit_cast(float, w4_.x & 0xffff0000u), __builtin_bit_cast(float, w4_.y << 16), __builtin_bit_cast(float, w4_.y & 0xffff0000u)}; } else pre4 = *(const f4*)(S.b4 + rr * S.ld4 + lcol); } \
        if (RW) { pre1 = *(const f4*)(S.b1 + rr * S.ld1 + lcol); pre2 = *(const f4*)(S.b2 + rr * S.ld2 + lcol); } } while (0)
    const int nblk = nsteps >> 2;
    SCAN_LOAD(t0);
#pragma unroll 1
    for (int blk = 0; blk < nblk; ++blk) {
        asm volatile("s_waitcnt lgkmcnt(0)" ::: "memory");
        { float* d = ldsw + lrow * 64 + lcol;
            *(f4*)(d + 0 * 256) = pre0; *(f4*)(d + 3 * 256) = pre3; *(f4*)(d + 5 * 256) = pre5;
            if (WY) *(f4*)(d + 4 * 256) = pre4;
            if (RW) { *(f4*)(d + 1 * 256) = pre1; *(f4*)(d + 2 * 256) = pre2; } }
        asm volatile("s_waitcnt lgkmcnt(0)" ::: "memory");
        if (blk + 1 < nblk) SCAN_LOAD(t0 + (blk + 1) * 4);
#pragma unroll 1
        for (int st = 0; st < 4; ++st) {
            const float* Lp = ldsw + st * 64;
            const f4 wA = *(const f4*)(Lp + 0 * 256 + j * 8), wB = *(const f4*)(Lp + 0 * 256 + j * 8 + 4);
            const f4 kA = *(const f4*)(Lp + 3 * 256 + j * 8), kB = *(const f4*)(Lp + 3 * 256 + j * 8 + 4);
            const f4 vA = *(const f4*)(Lp + 5 * 256 + g * 8), vB = *(const f4*)(Lp + 5 * 256 + g * 8 + 4);
            f4 aA, aB, bA, bB, rA, rB;
            if (RW) { aA = *(const f4*)(Lp + 1 * 256 + j * 8); aB = *(const f4*)(Lp + 1 * 256 + j * 8 + 4); bA = *(const f4*)(Lp + 2 * 256 + j * 8); bB = *(const f4*)(Lp + 2 * 256 + j * 8 + 4); }
            if (WY) { rA = *(const f4*)(Lp + 4 * 256 + j * 8); rB = *(const f4*)(Lp + 4 * 256 + j * 8 + 4); }
            const f2 w2[4] = {(f2){wA[0], wA[1]}, (f2){wA[2], wA[3]}, (f2){wB[0], wB[1]}, (f2){wB[2], wB[3]}};
            f2 k2[4] = {(f2){kA[0], kA[1]}, (f2){kA[2], kA[3]}, (f2){kB[0], kB[1]}, (f2){kB[2], kB[3]}};
            f2 a2[4], b2[4], r2[4];
            if (RW) { a2[0] = (f2){aA[0], aA[1]}; a2[1] = (f2){aA[2], aA[3]}; a2[2] = (f2){aB[0], aB[1]}; a2[3] = (f2){aB[2], aB[3]};
                      b2[0] = (f2){bA[0], bA[1]}; b2[1] = (f2){bA[2], bA[3]}; b2[2] = (f2){bB[0], bB[1]}; b2[3] = (f2){bB[2], bB[3]};
#pragma unroll
                      for (int q = 0; q < 4; ++q) { k2[q] = k2[q] * (b2[q] * ka2[q] + (1.0f - ka2[q])); b2[q] = -(a2[q] * b2[q]); } }
            if (WY) { r2[0] = (f2){rA[0], rA[1]}; r2[1] = (f2){rA[2], rA[3]}; r2[2] = (f2){rB[0], rB[1]}; r2[3] = (f2){rB[2], rB[3]}; }
            const float vv[8] = {vA[0], vA[1], vA[2], vA[3], vB[0], vB[1], vB[2], vB[3]};
            float ysel = 0.f;
            if (RW) {
                float d[8];
#pragma unroll
                for (int i = 0; i < 8; ++i) { f2 d2 = s[i][0] * a2[0]; d2 += s[i][1] * a2[1]; d2 += s[i][2] * a2[2]; d2 += s[i][3] * a2[3]; d[i] = d2[0] + d2[1]; }
#pragma unroll
                for (int i = 0; i < 8; ++i) d[i] += dppf<0xB1>(d[i]);
#pragma unroll
                for (int i = 0; i < 8; ++i) d[i] += dppf<0x4E>(d[i]);
#pragma unroll
                for (int i = 0; i < 8; ++i) d[i] += dppf<0x141>(d[i]);
#pragma unroll
                for (int i = 0; i < 8; ++i) { const float vi = vv[i] * vks;
#pragma unroll
                    for (int q = 0; q < 4; ++q) s[i][q] = s[i][q] * w2[q] + (d[i] * b2[q] + vi * k2[q]); }
            } else {
#pragma unroll
                for (int i = 0; i < 8; ++i) { const float vi = vv[i] * vks;
#pragma unroll
                    for (int q = 0; q < 4; ++q) s[i][q] = s[i][q] * w2[q] + vi * k2[q]; }
            }
            if (WY) {
                float y[8];
#pragma unroll
                for (int i = 0; i < 8; ++i) { f2 y2 = s[i][0] * r2[0]; y2 += s[i][1] * r2[1]; y2 += s[i][2] * r2[2]; y2 += s[i][3] * r2[3]; y[i] = y2[0] + y2[1]; }
#pragma unroll
                for (int i = 0; i < 8; ++i) y[i] += dppf<0xB1>(y[i]);
#pragma unroll
                for (int i = 0; i < 8; ++i) y[i] += dppf<0x4E>(y[i]);
#pragma unroll
                for (int i = 0; i < 8; ++i) y[i] += dppf<0x141>(y[i]);
#pragma unroll
                for (int i = 0; i < 8; ++i) ysel = (j == i) ? y[i] : ysel;
            }
            if (!RW) {
#pragma unroll
                for (int q = 0; q < 4; ++q) pd[q] *= w2[q];
            }
            if (WY) yout[(size_t)(t0 + blk * 4 + st) * ldy + lane] = to_bf16(ysel * yscale);
            if (RW && WY) {
                f2 bb = (r2[0] * k2[0]) * rk2[0]; bb += (r2[1] * k2[1]) * rk2[1]; bb += (r2[2] * k2[2]) * rk2[2]; bb += (r2[3] * k2[3]) * rk2[3];
                const float bsum = red8(bb[0] + bb[1]);
                if (lane == 0) bdout[(size_t)(t0 + blk * 4 + st) * 16] = bsum; }
        }
    }
#undef SCAN_LOAD
}
template <bool RW, bool VK>
__device__ __forceinline__ void scan_run_ring(const int wv_, float* ldsw  , const ScanSrc& S, int t0, int nsteps, f2 (&s)[8][4], f2 (&pd)[4], const f2 (&ka2)[4], float vks) {
    const int lane = TIDX & 63, j = lane & 7, g = lane >> 3, lrow = lane >> 4, lcol = (lane & 15) * 4;
    const int nblk = nsteps >> 2;
    LAS unsigned char* l3 = (LAS unsigned char*)ldsw;
#define RING_ISSUE(bb) do { const int b_ = ((bb) < nblk) ? (bb) : (nblk - 1); const size_t rr = (size_t)(t0 + b_ * 4 + lrow); LAS unsigned char* dst_ = l3 + ((bb) % 3) * 6144; \
        __builtin_amdgcn_global_load_lds((const unsigned*)(S.b0 + rr * S.ld0 + lcol), (LAS unsigned*)(dst_ + 0 * 1024), 16, 0, 0); \
        __builtin_amdgcn_global_load_lds((const unsigned*)(S.b1 + rr * S.ld1 + lcol), (LAS unsigned*)(dst_ + 1 * 1024), 16, 0, 0); \
        __builtin_amdgcn_global_load_lds((const unsigned*)(S.b2 + rr * S.ld2 + lcol), (LAS unsigned*)(dst_ + 2 * 1024), 16, 0, 0); \
        __builtin_amdgcn_global_load_lds((const unsigned*)(S.b3 + rr * S.ld3 + lcol), (LAS unsigned*)(dst_ + 3 * 1024), 16, 0, 0); \
        __builtin_amdgcn_global_load_lds((const unsigned*)(S.b5 + rr * S.ld5 + lcol), (LAS unsigned*)(dst_ + 5 * 1024), 16, 0, 0); } while (0)
    RING_ISSUE(0); RING_ISSUE(1);
#pragma unroll 1
    for (int blk = 0; blk < nblk; ++blk) {
        asm volatile("s_waitcnt lgkmcnt(0)" ::: "memory");
        RING_ISSUE(blk + 2);
        asm volatile("s_waitcnt vmcnt(10)" ::: "memory");
        const float* Lb = ldsw + (blk % 3) * 1536;
#pragma unroll 1
        for (int st = 0; st < 4; ++st) {
            const float* Lp = Lb + st * 64;
            const f4 wA = *(const f4*)(Lp + 0 * 256 + j * 8), wB = *(const f4*)(Lp + 0 * 256 + j * 8 + 4);
            const f4 kA = *(const f4*)(Lp + 3 * 256 + j * 8), kB = *(const f4*)(Lp + 3 * 256 + j * 8 + 4);
            const f4 vA = *(const f4*)(Lp + 5 * 256 + g * 8), vB = *(const f4*)(Lp + 5 * 256 + g * 8 + 4);
            const f2 w2[4] = {(f2){wA[0], wA[1]}, (f2){wA[2], wA[3]}, (f2){wB[0], wB[1]}, (f2){wB[2], wB[3]}};
            f2 k2[4] = {(f2){kA[0], kA[1]}, (f2){kA[2], kA[3]}, (f2){kB[0], kB[1]}, (f2){kB[2], kB[3]}};
            const float vv[8] = {vA[0], vA[1], vA[2], vA[3], vB[0], vB[1], vB[2], vB[3]};
            if (RW) {
                const f4 aA = *(const f4*)(Lp + 1 * 256 + j * 8), aB = *(const f4*)(Lp + 1 * 256 + j * 8 + 4), bA = *(const f4*)(Lp + 2 * 256 + j * 8), bB = *(const f4*)(Lp + 2 * 256 + j * 8 + 4);
                const f2 a2[4] = {(f2){aA[0], aA[1]}, (f2){aA[2], aA[3]}, (f2){aB[0], aB[1]}, (f2){aB[2], aB[3]}};
                f2 b2[4] = {(f2){bA[0], bA[1]}, (f2){bA[2], bA[3]}, (f2){bB[0], bB[1]}, (f2){bB[2], bB[3]}};
#pragma unroll
                for (int q = 0; q < 4; ++q) { if (VK) k2[q] = k2[q] * (b2[q] * ka2[q] + (1.0f - ka2[q])); b2[q] = -(a2[q] * b2[q]); }
                float d[8];
#pragma unroll
                for (int i = 0; i < 8; ++i) { f2 d2 = s[i][0] * a2[0]; d2 += s[i][1] * a2[1]; d2 += s[i][2] * a2[2]; d2 += s[i][3] * a2[3]; d[i] = d2[0] + d2[1]; }
#pragma unroll
                for (int i = 0; i < 8; ++i) d[i] += dppf<0xB1>(d[i]);
#pragma unroll
                for (int i = 0; i < 8; ++i) d[i] += dppf<0x4E>(d[i]);
#pragma unroll
                for (int i = 0; i < 8; ++i) d[i] += dppf<0x141>(d[i]);
#pragma unroll
                for (int i = 0; i < 8; ++i) { const float vi = vv[i] * vks;
#pragma unroll
                    for (int q = 0; q < 4; ++q) { if (VK) s[i][q] = s[i][q] * w2[q] + (d[i] * b2[q] + vi * k2[q]); else s[i][q] = s[i][q] * w2[q] + d[i] * b2[q]; } }
            } else {
#pragma unroll
                for (int i = 0; i < 8; ++i) { const float vi = vv[i] * vks;
#pragma unroll
                    for (int q = 0; q < 4; ++q) s[i][q] = s[i][q] * w2[q] + vi * k2[q]; }
#pragma unroll
                for (int q = 0; q < 4; ++q) pd[q] *= w2[q];
            }
        }
    }
    asm volatile("s_waitcnt vmcnt(0)" ::: "memory");
#undef RING_ISSUE
}
__device__ __forceinline__ ScanSrc rwkv_src(unsigned char* ws, int L, int h) {
    ScanSrc S; S.b0 = (const float*)(ws + WS_W) + h * 64; S.b1 = (const float*)(ws + WS_A) + h * 64; S.b2 = (const float*)(ws + WS_B) + h * 64; S.b3 = (const float*)(ws + WS_K) + h * 64;
    S.b4 = (const float*)((const u16*)(ws + WS_R) + h * 64);     S.b5 = (const float*)(ws + (L == 0 ? WS_V0 : WS_V1)) + h * 64; S.ld0 = S.ld1 = S.ld2 = S.ld3 = S.ld4 = S.ld5 = 1024; return S;
}
__device__ __forceinline__ ScanSrc gla_src(unsigned char* ws, int hd, int half) {
    const float* zG = (const float*)(ws + WS_ZG);
    ScanSrc S; S.b0 = (const float*)(ws + WS_ALPHA) + hd * 64; S.ld0 = 512; S.b1 = S.b0; S.b2 = S.b0; S.ld1 = S.ld2 = 512;
    S.b3 = zG + 512 + hd * 64; S.ld3 = NG; S.b4 = zG + hd * 64; S.ld4 = NG; S.b5 = zG + 1024 + hd * 128 + half * 64; S.ld5 = NG; return S;
}
__device__ __forceinline__ void state_store(const int wv_, float* dst  , const f2 (&s)[8][4]) {
    const int lane = TIDX & 63, j = lane & 7, g = lane >> 3;
#pragma unroll
    for (int i = 0; i < 8; ++i) { float* d = dst + (size_t)(g * 8 + i) * 64 + j * 8;
        *(f4*)(d) = (f4){s[i][0][0], s[i][0][1], s[i][1][0], s[i][1][1]}; *(f4*)(d + 4) = (f4){s[i][2][0], s[i][2][1], s[i][3][0], s[i][3][1]}; }
}
__device__ __forceinline__ void state_load(const int wv_, const float* src, f2 (&s)[8][4]) {
    const int lane = TIDX & 63, j = lane & 7, g = lane >> 3;
#pragma unroll
    for (int i = 0; i < 8; ++i) { const float* d = src + (size_t)(g * 8 + i) * 64 + j * 8; const f4 x = *(const f4*)(d), y = *(const f4*)(d + 4);
        s[i][0] = (f2){x[0], x[1]}; s[i][1] = (f2){x[2], x[3]}; s[i][2] = (f2){y[0], y[1]}; s[i][3] = (f2){y[2], y[3]}; }
}
__device__ __forceinline__ void phase_scan1(const int wv_, const Params& p, int L, float* ldsf) {
    unsigned char* ws = launder_p(p.ws);
    const int wave = __builtin_amdgcn_readfirstlane(TIDX >> 6), lane = TIDX & 63, j = lane & 7, g = lane >> 3;
    float* ldsw = ldsf + wave * 4608;
    for (int tb = blockIdx.x; tb < 252; tb += gridDim.x) {
        f2 s[8][4]; f2 pd[4];
#pragma unroll
        for (int q = 0; q < 4; ++q) pd[q] = (f2){1.f, 1.f};
        const bool isM = wave >= 4; const int idx = tb * 4 + (wave & 3); const int h = idx / 63, c = idx % 63;
#pragma unroll
        for (int i = 0; i < 8; ++i)
#pragma unroll
            for (int q = 0; q < 4; ++q) { const int e = j * 8 + q * 2, r = g * 8 + i; s[i][q] = (f2){(isM && e == r) ? 1.f : 0.f, (isM && e + 1 == r) ? 1.f : 0.f}; }
        const ScanSrc S = rwkv_src(ws, L, h);
        f2 ka2[4]; { const float* kp = p.in[19] + L * 1024 + h * 64 + j * 8; const f4 x = *(const f4*)(kp), y = *(const f4*)(kp + 4); ka2[0] = (f2){x[0], x[1]}; ka2[1] = (f2){x[2], x[3]}; ka2[2] = (f2){y[0], y[1]}; ka2[3] = (f2){y[2], y[3]}; }
        if (isM) scan_run_ring<true, false>(wv_, ldsw, S, c * 128, 128, s, pd, ka2, 0.f); else scan_run_ring<true, true>(wv_, ldsw, S, c * 128, 128, s, pd, ka2, 1.f);
        if (isM) { float* mt = (float*)(ws + WS_MB) + (size_t)(h * 64 + c) * 4096;
#pragma unroll
            for (int i = 0; i < 8; ++i)
#pragma unroll
                for (int q = 0; q < 4; ++q) { mt[(size_t)(j * 8 + q * 2) * 64 + g * 8 + i] = s[i][q][0]; mt[(size_t)(j * 8 + q * 2 + 1) * 64 + g * 8 + i] = s[i][q][1]; } }
        else state_store(wv_, (float*)(ws + WS_NB) + (size_t)(h * 64 + c) * 4096, s);
    }
    for (int tb = blockIdx.x; tb < 252; tb += gridDim.x) {
        f2 s[8][4]; f2 pd[4];
#pragma unroll
        for (int q = 0; q < 4; ++q) pd[q] = (f2){1.f, 1.f};
        const bool active = wave < 4;
        const int idx = tb * 4 + (wave & 3); const int hh = idx / 63, c = idx % 63, hd = hh >> 1, half = hh & 1;
#pragma unroll
        for (int i = 0; i < 8; ++i)
#pragma unroll
            for (int q = 0; q < 4; ++q) s[i][q] = (f2){0.f, 0.f};
        const ScanSrc S = gla_src(ws, hd, half); const f2 pd0[4] = {(f2){1.f, 1.f}, (f2){1.f, 1.f}, (f2){1.f, 1.f}, (f2){1.f, 1.f}};
        if (active) scan_run_ring<false, true>(wv_, ldsw, S, c * 128, 128, s, pd, pd0, 1.f);
        if (active) {
            state_store(wv_, (float*)(ws + WS_NGB) + ((size_t)(hd * 64 + c) * 128 + half * 64) * 64, s);
            if (half == 0 && g == 0) { float* d = (float*)(ws + WS_PGB) + (size_t)(hd * 64 + c) * 64 + j * 8;
                *(f4*)(d) = (f4){pd[0][0], pd[0][1], pd[1][0], pd[1][1]}; *(f4*)(d + 4) = (f4){pd[2][0], pd[2][1], pd[3][0], pd[3][1]}; }
        }
    }
}
__device__ __forceinline__ void phase_scan2(const int wv_, const Params& p, float* ldsM) {
    unsigned char* ws = launder_p(p.ws); const int tid = TIDX, lane = tid & 63, wave = tid >> 6;
    const float* MB = (const float*)(ws + WS_MB); const float* NB = (const float*)(ws + WS_NB); float* SB = (float*)(ws + WS_SB);
    const float* NGB = (const float*)(ws + WS_NGB); const float* PGB = (const float*)(ws + WS_PGB); float* SGB = (float*)(ws + WS_SGB);
    { const int q = blockIdx.x;
        if (q < 128) {
            const int h = (q & 7) + 8 * (q >> 6), r = ((q >> 3) & 7) * 8 + wave;
            f4 mr[16]; float nr[8]; float s = 0.f;
#pragma unroll
            for (int i = 0; i < 16; ++i) mr[i] = (f4){0.f, 0.f, 0.f, 0.f};
#pragma unroll
            for (int i = 0; i < 8; ++i) nr[i] = 0.f;
#define P2_LOADB(bb) do { const int c0_ = (bb) * 8; \
                _Pragma("unroll") for (int i = 0; i < 16; ++i) { const int m_ = i >> 1; const int cc_ = (c0_ + m_ < 63) ? c0_ + m_ : 62; mr[i] = *(const f4*)(MB + (size_t)(h * 64 + cc_) * 4096 + (i & 1) * 2048 + tid * 4); } \
                _Pragma("unroll") for (int m_ = 0; m_ < 8; ++m_) { const int cc_ = (c0_ + m_ < 63) ? c0_ + m_ : 62; nr[m_] = NB[((size_t)(h * 64 + cc_) * 64 + r) * 64 + lane]; } } while (0)
            P2_LOADB(0);
#pragma unroll 1
            for (int b = 0; b < 8; ++b) {
                __syncthreads();
#pragma unroll
                for (int i = 0; i < 16; ++i) { const int x = (i & 1) * 2048 + tid * 4; *(f4*)(ldsM + (i >> 1) * 4352 + (x >> 6) * 68 + (x & 63)) = mr[i]; }
                float nv[8];
#pragma unroll
                for (int m = 0; m < 8; ++m) nv[m] = nr[m];
                __syncthreads();
                P2_LOADB((b + 1 < 8) ? b + 1 : 7);
                float* sv = ldsM + 8 * 4352 + wave * 64;
#pragma unroll
                for (int m = 0; m < 8; ++m) { const int cc = b * 8 + m;
                    if (cc < 63) {
                        sv[lane] = s;
                        asm volatile("s_waitcnt lgkmcnt(0)" ::: "memory");
                        const float* Mrow = ldsM + m * 4352 + lane * 68;
                        f4 mq[16], sq[16];
#pragma unroll
                        for (int k4 = 0; k4 < 16; ++k4) { mq[k4] = *(const f4*)(Mrow + k4 * 4); sq[k4] = *(const f4*)(sv + k4 * 4); }
                        f4 a4 = (f4){nv[m], 0.f, 0.f, 0.f};
#pragma unroll
                        for (int k4 = 0; k4 < 16; ++k4) a4 += mq[k4] * sq[k4];
                        s = (a4[0] + a4[1]) + (a4[2] + a4[3]);
                        SB[((size_t)(h * 64 + cc + 1) * 64 + r) * 64 + lane] = s; }
                    asm volatile("" ::: "memory"); }
            }
#undef P2_LOADB
        } else if (q < 256) {
            const int idx = (q - 128) * 512 + tid; const int hd = idx >> 13, row = (idx >> 6) & 127, e = idx & 63;
            float s = 0.f;
#pragma unroll 1
            for (int cb = 0; cb < 63; cb += 9) { float pv[9], nv[9];
#pragma unroll
                for (int i = 0; i < 9; ++i) { pv[i] = PGB[(size_t)(hd * 64 + cb + i) * 64 + e]; nv[i] = NGB[((size_t)(hd * 64 + cb + i) * 128 + row) * 64 + e]; }
                asm volatile("" ::: "memory");
#pragma unroll
                for (int i = 0; i < 9; ++i) { s = pv[i] * s + nv[i]; SGB[((size_t)(hd * 64 + cb + i + 1) * 128 + row) * 64 + e] = s; } }
        }
    }
}
__device__ __forceinline__ void phase_scan3(const int wv_, const Params& p, int L, float* ldsf) {
    unsigned char* ws = launder_p(p.ws);
    const int wave = __builtin_amdgcn_readfirstlane(TIDX >> 6);
    float* ldsw = ldsf + wave * 1536;
    for (int tb = blockIdx.x; tb < 256; tb += gridDim.x) {
        f2 s[8][4]; f2 pd[4];
#pragma unroll
        for (int q = 0; q < 4; ++q) pd[q] = (f2){1.f, 1.f};
#pragma unroll
        for (int i = 0; i < 8; ++i)
#pragma unroll
            for (int q = 0; q < 4; ++q) s[i][q] = (f2){0.f, 0.f};
        if (wave < 4) {
            const int idx = tb * 4 + wave; const int h = idx >> 6, c = idx & 63;
            if (c > 0) state_load(wv_, (const float*)(ws + WS_SB) + (size_t)(h * 64 + c) * 4096, s);
            const ScanSrc S = rwkv_src(ws, L, h);
            f2 ka2[4]; { const float* kp = p.in[19] + L * 1024 + h * 64 + (lane_id_v() & 7) * 8; const f4 x = *(const f4*)(kp), y = *(const f4*)(kp + 4); ka2[0] = (f2){x[0], x[1]}; ka2[1] = (f2){x[2], x[3]}; ka2[2] = (f2){y[0], y[1]}; ka2[3] = (f2){y[2], y[3]}; }
            f2 rk2[4]; { const float* rp = p.in[20] + L * 1024 + h * 64 + (lane_id_v() & 7) * 8; const f4 x = *(const f4*)(rp), y = *(const f4*)(rp + 4); rk2[0] = (f2){x[0], x[1]}; rk2[1] = (f2){x[2], x[3]}; rk2[2] = (f2){y[0], y[1]}; rk2[3] = (f2){y[2], y[3]}; }
            scan_run<true, true>(wv_, ldsw, S, c * 128, 128, s, pd, ka2, 1.f, (u16*)(ws + WS_YR) + h * 64, 1024, 1.0f, true, rk2, (float*)(ws + WS_BD) + h);
        } else {
            const int idx = tb * 4 + wave - 4; const int hh = idx >> 6, c = idx & 63, hd = hh >> 1, half = hh & 1;
            if (c > 0) state_load(wv_, (const float*)(ws + WS_SGB) + ((size_t)(hd * 64 + c) * 128 + half * 64) * 64, s);
            const ScanSrc S = gla_src(ws, hd, half); const f2 pd0[4] = {(f2){1.f, 1.f}, (f2){1.f, 1.f}, (f2){1.f, 1.f}, (f2){1.f, 1.f}};
            scan_run<false, true>(wv_, ldsw, S, c * 128, 128, s, pd, pd0, 1.f, (u16*)(ws + WS_OG) + hd * 128 + half * 64, 1024, 0.125f);
        }
    }
}
__device__ __forceinline__ f4 ld_bf16x4(const u16* p) { const u32x2 w = *(const u32x2*)p; return (f4){__builtin_bit_cast(float, w.x << 16), __builtin_bit_cast(float, w.x & 0xffff0000u), __builtin_bit_cast(float, w.y << 16), __builtin_bit_cast(float, w.y & 0xffff0000u)}; }
__device__ __forceinline__ void phase_post(const int wv_, const Params& p, int L) {
    unsigned char* ws = launder_p(p.ws); const int lane = TIDX & 63, w = TIDX >> 6;
    const u16* OG = (const u16*)(ws + WS_OG); const u16* YR = (const u16*)(ws + WS_YR); const float* zG = (const float*)(ws + WS_ZG);
    const float* R = (const float*)(ws + WS_R); const float* K = (const float*)(ws + WS_K); const float* ALR = (const float*)(ws + WS_B); const float* V = (const float*)(ws + (L == 0 ? WS_V0 : WS_V1)); const u16* G = (const u16*)(ws + WS_GATE); const float* BD = (const float*)(ws + WS_BD); const u16* GGp = (const u16*)(ws + WS_GG);
    u16* mixA = (u16*)(ws + WS_HA);
    const int xaddr = (lane ^ 16) << 2;
    for (int t = blockIdx.x * 8 + w; t < T; t += gridDim.x * 8) {
#pragma unroll
        for (int ch = 0; ch < 4; ++ch) { const int c = ch * 256 + lane * 4;
            const f4 o = ld_bf16x4(OG + (size_t)t * 1024 + c), gg = ld_bf16x4(GGp + (size_t)t * 1024 + c), nw = *(const f4*)(p.in[11] + L * 1024 + c);
            float ss = red16(o[0] * o[0] + o[1] * o[1] + o[2] * o[2] + o[3] * o[3]);
            ss += __builtin_bit_cast(float, __builtin_amdgcn_ds_bpermute(xaddr, __builtin_bit_cast(int, ss)));
            const float rs = rsqrtf(ss * (1.0f / 128.0f) + 1e-6f);
            float r[4];
#pragma unroll
            for (int q = 0; q < 4; ++q) r[q] = ((o[q] * rs) * nw[q]) * (gg[q] * sigm(gg[q]));
            u32x2 wv; wv.x = pk_bf16(r[0], r[1]); wv.y = pk_bf16(r[2], r[3]); *(u32x2*)(mixA + (size_t)t * 2048 + c) = wv; }
#pragma unroll
        for (int ch = 0; ch < 4; ++ch) { const int c = ch * 256 + lane * 4; const size_t o = (size_t)t * 1024 + c;
            const f4 y = ld_bf16x4(YR + o), v = *(const f4*)(V + o), gt = ld_bf16x4(G + o);
            const f4 gw = *(const f4*)(p.in[21] + L * 1024 + c), gb = *(const f4*)(p.in[22] + L * 1024 + c);
            const float bs = BD[(size_t)t * 16 + ch * 4 + (lane >> 4)];
            const float mean = red16((y[0] + y[1]) + (y[2] + y[3])) * (1.0f / 64.0f); const f4 d = y - mean;
            const float var = red16(d[0] * d[0] + d[1] * d[1] + d[2] * d[2] + d[3] * d[3]) * (1.0f / 64.0f); const float rs = rsqrtf(var + 64e-5f);
            const f4 out = ((d * rs) * gw + gb + bs * v) * gt;
            u32x2 wv; wv.x = pk_bf16(out[0], out[1]); wv.y = pk_bf16(out[2], out[3]); *(u32x2*)(mixA + (size_t)t * 2048 + 1024 + c) = wv; }
    }
}
template <class Epi> __device__ __forceinline__ void run_gemm(const int wv_, unsigned char* lds, const u16* A, const u16* Bt, int M, int N, int K, const Epi& E) {
    M = launder_s(M); N = launder_s(N); K = launder_s(K);
    pg8::Gemm g{A, Bt, M, N, K, A, 1 << 30, 1 << 30}; pg8::StaticOrder S; S.init(M, N, (int)gridDim.x, (int)blockIdx.x);
    pg8::gemm_phase<Epi, pg8::StaticOrder, false>(wv_, (PG8_LAS unsigned char*)lds, g, S, E, nullptr);
}
#define WSP() unsigned char* ws = launder_p(p.ws); const float* mod = (const float*)(ws + WS_MOD); u16* hA = (u16*)(ws + WS_HA); u16* Y = (u16*)(ws + WS_Y); (void)mod; (void)hA; (void)Y
#ifndef DUP_MASK
#define DUP_MASK 0
#endif
#define REP(bit) for (int rep_ = 0, nrep_ = 1 + ((launder_s(DUP_MASK) >> (bit)) & 1); rep_ < nrep_; ++rep_)
#define BAR() xcd_barrier(wv_, xb)
__global__ void __launch_bounds__(512) mega(Params p) {
    extern __shared__ __attribute__((aligned(16))) unsigned char lds[];
    cg::grid_group grid = cg::this_grid();
    float* ldsf = (float*)lds;
    const int wv_ = __builtin_amdgcn_readfirstlane((int)threadIdx.x >> 6);
    if (p.ws == nullptr) grid.sync();
    volatile LAS unsigned* xst = (volatile LAS unsigned*)((LAS unsigned char*)lds + 147456);
    if (TIDX < 4) xst[TIDX] = 0u;
    __syncthreads();
    const XcdBarrier xb = xcd_barrier_post(wv_, (unsigned*)(p.ws + WS_CTL), xst);
    phase_ada(wv_, p, ldsf); phase_conv(wv_, p, 0, ldsf);
    BAR();
    REP(10) { phase_ada(wv_, p, ldsf); phase_conv(wv_, p, 0, ldsf); BAR(); }
    REP(12) { WSP(); phase_rowwise(wv_, p.in[0], nullptr, nullptr, nullptr, nullptr, p.in[4], mod + 2048, mod, hA); BAR(); }
#pragma unroll 1
    for (int L0 = 0; L0 < 2; ++L0) {
        REP(0) { WSP(); EpiZ E{(float*)(ws + WS_ZG), (u16*)(ws + WS_ZR), (u16*)(ws + WS_GG)}; run_gemm(wv_, lds, hA, (const u16*)(ws + WS_WIN), T, NINP, 2048, E); BAR(); }
        REP(1) { phase_prep(wv_, p, launder_s(L0)); BAR(); }
        { WSP(); const int L = launder_s(L0);
          EpiGen4 E{(float*)(ws + WS_W), (float*)(ws + WS_B), (float*)(ws + WS_GATE), (float*)(ws + WS_V1), p.in[13] + L * 1024, p.in[15] + L * 1024, p.in[26], (const float*)(ws + WS_V0)};
          const int M_ = launder_s(T), N_ = launder_s(L == 0 ? 3072 : 4096), K_ = launder_s(256);
          pg8::Gemm g{(const u16*)(ws + WS_ACAT1), (const u16*)(ws + WS_LRT), M_, N_, K_, (const u16*)(ws + WS_ACAT2), 8, 12}; pg8::StaticOrder S; S.init(M_, N_, (int)gridDim.x, (int)blockIdx.x);
          pg8::gemm_phase<EpiGen4, pg8::StaticOrder, false>(wv_, (PG8_LAS unsigned char*)lds, g, S, E, nullptr); }
        BAR();
        REP(3) { phase_scan1(wv_, p, launder_s(L0), ldsf); BAR(); }
        REP(4) { phase_scan2(wv_, p, ldsf); BAR(); }
        REP(5) { phase_scan3(wv_, p, launder_s(L0), ldsf); BAR(); }
        REP(6) { phase_post(wv_, p, launder_s(L0)); BAR(); }
        REP(7) { WSP(); EpiBf16 E{Y, 2048}; run_gemm(wv_, lds, hA, (const u16*)(ws + WS_WOUT), T, 2048, 2048, E); BAR(); }
        { WSP(); const int L = launder_s(L0); const float* modL = mod + L * 12288;
          phase_rowwise(wv_, L == 0 ? p.in[0] : p.out, Y, modL + 4096, p.in[5] + L * 2048, p.out, p.in[6] + L * 2048, modL + 8192, modL + 6144, hA); }
        BAR();
        REP(8) { WSP(); EpiRelu2 E{(u16*)(ws + WS_U), 8192}; run_gemm(wv_, lds, hA, (const u16*)(ws + WS_WFF1), T, 8192, 2048, E); BAR(); }
        REP(9) { WSP(); EpiBf16 E{Y, 2048}; run_gemm(wv_, lds, (const u16*)(ws + WS_U), (const u16*)(ws + WS_WFF2), T, 2048, 8192, E); BAR(); }
        if (L0 == 0) {
            { WSP(); phase_rowwise(wv_, p.out, Y, mod + 10240, p.in[7], p.out, p.in[4] + 2048, mod + 12288 + 2048, mod + 12288, hA); }
            phase_conv(wv_, p, 1, ldsf);
            BAR();
        } else {
            { WSP(); phase_rowwise(wv_, p.out, Y, mod + 12288 + 10240, p.in[7] + 2048, p.out, nullptr, nullptr, nullptr, nullptr); }
        }
    }
}
extern "C" void kernel_launch(void* const* d_in, const int* in_sizes, int n_in, void* d_out, int out_size, void* d_ws, size_t ws_size, hipStream_t stream) {
    static int grid_blocks = 0;
    constexpr size_t kLds = 147456 + 64;
    if (!grid_blocks) {
        int dev = 0, cus = 0, per_cu = 0;
        (void)hipGetDevice(&dev);
        (void)hipDeviceGetAttribute(&cus, hipDeviceAttributeMultiprocessorCount, dev);
        (void)hipFuncSetAttribute((const void*)mega, hipFuncAttributeMaxDynamicSharedMemorySize, (int)kLds);
        (void)hipOccupancyMaxActiveBlocksPerMultiprocessor(&per_cu, (const void*)mega, 512, kLds);
        if (ws_size < WS_END || n_in != 30) { fprintf(stderr, "kernel_launch: workspace %zu < %zu or n_in %d != 30\n", ws_size, (size_t)WS_END, n_in); grid_blocks = -1; return; }
        if (per_cu < 1) fprintf(stderr, "kernel_launch: occupancy query says %d blocks/CU\n", per_cu);
        if (cus < 256) { fprintf(stderr, "kernel_launch: needs >= 256 CUs, device has %d\n", cus); grid_blocks = -1; return; }
        grid_blocks = cus;
    }
    if (grid_blocks < 0) return;
    (void)hipMemsetAsync((unsigned char*)d_ws + WS_CTL, 0, 16384, stream);
    Params p{};
    for (int i = 0; i < 30; ++i) p.in[i] = (const float*)d_in[i];
    p.out = (float*)d_out; p.ws = (unsigned char*)d_ws;
    void* args[] = {&p};
    hipError_t e = hipLaunchCooperativeKernel((void*)mega, dim3(grid_blocks), dim3(512), args, kLds, stream);
    if (e != hipSuccess) fprintf(stderr, "cooperative launch failed: %s (grid %d)\n", hipGetErrorString(e), grid_blocks);
}
```
